# Optimizing an MI355X kernel written in HIP

```python
import math
import jax, jax.numpy as jnp
from jax import lax
import numpy as np

D_MODEL = 1024
BATCH = 8
SEQ = 4096
DEPTH = 2

MIX_WIDTH = D_MODEL
LRU_WIDTH = MIX_WIDTH // 2
LRU_BLOCKS = 8
LRU_BLOCK_DIM = LRU_WIDTH // LRU_BLOCKS
CONV_WIDTH = 4
LRU_C = 8.0
N_HEADS = 8
HEAD_DIM = (MIX_WIDTH - LRU_WIDTH) // N_HEADS
N_KV = 2
Q_PER_KV = N_HEADS // N_KV
NSA_WIDTH = N_HEADS * HEAD_DIM
KV_WIDTH = N_KV * HEAD_DIM
N_BRANCHES = 3
CMP_BLOCK = 32
CMP_STRIDE = 16
SEL_BLOCK = 64
SEL_TOPN = 16
WINDOW = 512
Q_BLOCK = 128
FORCE_BONUS = 1e4
NEG = -1e30
PEER_HEADS = 8
PEER_KEYS = 128
PEER_TOPK = 16
PEER_KEY_DIM = 128
N_EXPERTS = PEER_KEYS * PEER_KEYS
PEER_CHUNK = 512
IN_SPLITS = (LRU_WIDTH, LRU_WIDTH, NSA_WIDTH, KV_WIDTH, KV_WIDTH, KV_WIDTH, KV_WIDTH, KV_WIDTH, KV_WIDTH, N_HEADS * N_BRANCHES)
IN_COLS = sum(IN_SPLITS)
ALPHA = (2 * DEPTH) ** 0.25
BETA = (8 * DEPTH) ** -0.25
LN_EPS = 1e-5

kernel_name = 'hybrid_rglru_nsa_peer_deepnorm'


def _layer_norm(x, g, b):
    xf = x.astype(jnp.float32)
    mu = jnp.mean(xf, -1, keepdims=True)
    var = jnp.mean(jnp.square(xf - mu), -1, keepdims=True)
    return ((xf - mu) * lax.rsqrt(var + LN_EPS) * g.astype(jnp.float32) + b.astype(jnp.float32)).astype(x.dtype)


def _rms_norm(x, g):
    xf = x.astype(jnp.float32)
    return (xf * lax.rsqrt(jnp.mean(jnp.square(xf), -1, keepdims=True) + LN_EPS) * g.astype(jnp.float32)).astype(x.dtype)


def _alibi_slopes(n):
    return jnp.asarray(np.array([2.0 ** (-8.0 * (h + 1) / n) for h in range(n)], np.float32))


def _rg_lru(xb, gate, conv_w, conv_b, wa, ba, wx, bx, lam):
    B, S, C = xb.shape
    xc = lax.conv_general_dilated(xb, conv_w[:, None, :], window_strides=(1,), padding=[(CONV_WIDTH - 1, 0)],
                                  dimension_numbers=('NWC', 'WIO', 'NWC'), feature_group_count=C) + conv_b
    xr = xc.reshape(B, S, LRU_BLOCKS, LRU_BLOCK_DIM)
    r = jax.nn.sigmoid(jnp.einsum('bsnd,nde->bsne', xr, wa) + ba.reshape(LRU_BLOCKS, LRU_BLOCK_DIM)).reshape(B, S, C)
    i = jax.nn.sigmoid(jnp.einsum('bsnd,nde->bsne', xr, wx) + bx.reshape(LRU_BLOCKS, LRU_BLOCK_DIM)).reshape(B, S, C)
    log_a = -LRU_C * r.astype(jnp.float32) * jax.nn.softplus(-lam.astype(jnp.float32))
    a = jnp.exp(log_a)
    u = jnp.sqrt(-jnp.expm1(2.0 * log_a)) * (i * xc).astype(jnp.float32)

    def combine(left, right):
        a1, b1 = left
        a2, b2 = right
        return a1 * a2, a2 * b1 + b2

    _, h = lax.associative_scan(combine, (a, u), axis=1)
    return h.astype(xb.dtype) * jax.nn.gelu(gate)


def _compress(k, pos, w1, b1, w2, b2):
    B, S, G, hd = k.shape
    nc = (S - CMP_BLOCK) // CMP_STRIDE + 1
    idx = np.arange(nc)[:, None] * CMP_STRIDE + np.arange(CMP_BLOCK)[None, :]
    blk = k[:, idx] + pos[None, None, :, None, :]
    flat = blk.transpose(0, 1, 3, 2, 4).reshape(B, nc, G, CMP_BLOCK * hd)
    return jax.nn.gelu(flat @ w1 + b1) @ w2 + b2


def _selection_matrix(n_cmp, n_sel):
    cs = np.arange(n_cmp)[:, None] * CMP_STRIDE
    ss = np.arange(n_sel)[None, :] * SEL_BLOCK
    ov = np.clip(np.minimum(cs + CMP_BLOCK, ss + SEL_BLOCK) - np.maximum(cs, ss), 0, None)
    return (ov / CMP_STRIDE).astype(np.float32)


def _nsa(q, kc, vc, ks, vs, kw, vw, gates):
    B, S = q.shape[:2]
    G, R, hd = N_KV, Q_PER_KV, HEAD_DIM
    nb = S // Q_BLOCK
    qb_all = (q * (hd ** -0.5)).reshape(B, nb, Q_BLOCK, G, R, hd).transpose(1, 0, 2, 3, 4, 5)
    g_all = jax.nn.sigmoid(gates).reshape(B, nb, Q_BLOCK, G, R, N_BRANCHES).transpose(1, 0, 2, 3, 4, 5)
    slopes = _alibi_slopes(N_HEADS).reshape(G, R)
    nc = kc.shape[1]
    cmp_end = jnp.arange(nc) * CMP_STRIDE + CMP_BLOCK - 1
    n_sel = S // SEL_BLOCK
    n_top = min(SEL_TOPN, n_sel)
    sel_mat = jnp.asarray(_selection_matrix(nc, n_sel))
    ks_blk = ks.transpose(0, 2, 1, 3).reshape(B, G, n_sel, SEL_BLOCK, hd)
    vs_blk = vs.transpose(0, 2, 1, 3).reshape(B, G, n_sel, SEL_BLOCK, hd)
    kw_pad = jnp.pad(kw, ((0, 0), (WINDOW, 0), (0, 0), (0, 0)))
    vw_pad = jnp.pad(vw, ((0, 0), (WINDOW, 0), (0, 0), (0, 0)))
    gather = jax.vmap(jax.vmap(lambda blk, ix: blk[ix]))
    blk_id = jnp.arange(n_sel)

    def one_block(args):
        qb, q_blk, g_blk = args
        t = qb * Q_BLOCK + jnp.arange(Q_BLOCK)
        s = jnp.einsum('bqgrd,bcgd->bgrqc', q_blk, kc).astype(jnp.float32)
        dist_c = (t[:, None] - cmp_end[None, :]).astype(jnp.float32)
        s = s - slopes[:, :, None, None] * jnp.abs(dist_c)
        valid_c = cmp_end[None, :] <= t[:, None]
        p_c = jax.nn.softmax(jnp.where(valid_c, s, NEG), axis=-1) * valid_c.any(-1)[:, None].astype(jnp.float32)
        o_c = jnp.einsum('bgrqc,bcgd->bqgrd', p_c.astype(vc.dtype), vc)
        imp = jnp.einsum('bgrqc,cj->bgqj', p_c, sel_mat)
        cur = t // SEL_BLOCK
        vblk = blk_id[None, :] <= cur[:, None]
        forced = (blk_id[None, :] == 0) | (blk_id[None, :] == cur[:, None]) | (blk_id[None, :] == cur[:, None] - 1)
        imp = jnp.where(vblk, imp + jnp.where(forced, FORCE_BONUS, 0.0), NEG)
        _, idx = lax.top_k(imp, n_top)
        k_sel = gather(ks_blk, idx)
        v_sel = gather(vs_blk, idx)
        tok = idx[..., None] * SEL_BLOCK + jnp.arange(SEL_BLOCK)
        dist_s = (t[None, None, :, None, None] - tok)[:, :, None]
        s = jnp.einsum('bqgrd,bgqnld->bgrqnl', q_blk, k_sel).astype(jnp.float32)
        s = s - slopes[None, :, :, None, None, None] * jnp.abs(dist_s).astype(jnp.float32)
        s = jnp.where(dist_s >= 0, s, NEG)
        p_s = jax.nn.softmax(s.reshape(s.shape[:4] + (n_top * SEL_BLOCK,)), axis=-1).reshape(s.shape)
        o_s = jnp.einsum('bgrqnl,bgqnld->bqgrd', p_s.astype(v_sel.dtype), v_sel)
        k_w = lax.dynamic_slice_in_dim(kw_pad, qb * Q_BLOCK, WINDOW + Q_BLOCK, axis=1)
        v_w = lax.dynamic_slice_in_dim(vw_pad, qb * Q_BLOCK, WINDOW + Q_BLOCK, axis=1)
        pos = qb * Q_BLOCK - WINDOW + jnp.arange(WINDOW + Q_BLOCK)
        dist_w = t[:, None] - pos[None, :]
        valid_w = (dist_w >= 0) & (dist_w < WINDOW) & (pos >= 0)[None, :]
        s = jnp.einsum('bqgrd,bkgd->bgrqk', q_blk, k_w).astype(jnp.float32)
        s = s - slopes[:, :, None, None] * dist_w.astype(jnp.float32)
        p_w = jax.nn.softmax(jnp.where(valid_w, s, NEG), axis=-1)
        o_w = jnp.einsum('bgrqk,bkgd->bqgrd', p_w.astype(v_w.dtype), v_w)
        return g_blk[..., 0:1] * o_c + g_blk[..., 1:2] * o_s + g_blk[..., 2:3] * o_w

    out = lax.map(one_block, (jnp.arange(nb), qb_all, g_all))
    return out.transpose(1, 0, 2, 3, 4, 5).reshape(B, S, N_HEADS * hd)


def _peer(x, wq, subkeys, u_tab, v_tab):
    B, S, D = x.shape
    T = B * S
    xf = x.reshape(T, D)
    q = (xf @ wq).reshape(T, PEER_HEADS, 2, PEER_KEY_DIM)
    s = jnp.einsum('thcd,ckd->thck', q, subkeys).astype(jnp.float32)
    sv, si = lax.top_k(s, PEER_TOPK)
    cand = (sv[:, :, 0, :, None] + sv[:, :, 1, None, :]).reshape(T, PEER_HEADS, PEER_TOPK * PEER_TOPK)
    cv, ci = lax.top_k(cand, PEER_TOPK)
    ea = jnp.take_along_axis(si[:, :, 0], ci // PEER_TOPK, axis=-1)
    eb = jnp.take_along_axis(si[:, :, 1], ci % PEER_TOPK, axis=-1)
    experts = (ea * PEER_KEYS + eb).reshape(T, PEER_HEADS * PEER_TOPK)
    gate = jax.nn.softmax(cv, axis=-1).reshape(T, PEER_HEADS * PEER_TOPK).astype(x.dtype)
    chunk = math.gcd(T, PEER_CHUNK)
    nch = T // chunk

    def one_chunk(args):
        xc, ec, gc = args
        act = jax.nn.gelu(jnp.einsum('cd,ced->ce', xc, u_tab[ec]))
        return jnp.einsum('ce,ced->cd', act * gc, v_tab[ec])

    y = lax.map(one_chunk, (xf.reshape(nch, chunk, D), experts.reshape(nch, chunk, -1), gate.reshape(nch, chunk, -1)))
    return y.reshape(B, S, D)


def setup_inputs(seed: int = 0) -> dict:
    key = jax.random.key(seed)
    ks = jax.random.split(key, 40)
    L = DEPTH

    def nrm(k, shape, scale):
        return jax.random.normal(k, shape, jnp.float32) * scale

    col_scale = np.concatenate([np.full(n, s, np.float32) for n, s in zip(
        IN_SPLITS, (BETA, 1.0, 1.0, 1.0, BETA, 1.0, BETA, 1.0, BETA, 1.0))])
    u = jax.random.uniform(ks[9], (L, LRU_WIDTH), jnp.float32, 0.9, 0.999)
    a0 = u ** (1.0 / LRU_C)
    fan_c = CMP_BLOCK * HEAD_DIM
    return {
        'x': nrm(ks[0], (BATCH, SEQ, D_MODEL), 1.0),
        'w_in': nrm(ks[1], (L, D_MODEL, IN_COLS), D_MODEL ** -0.5) * jnp.asarray(col_scale),
        'b_in': nrm(ks[2], (L, IN_COLS), 0.01),
        'conv_w': nrm(ks[3], (L, CONV_WIDTH, LRU_WIDTH), CONV_WIDTH ** -0.5),
        'conv_b': nrm(ks[4], (L, LRU_WIDTH), 0.01),
        'lru_wa': nrm(ks[5], (L, LRU_BLOCKS, LRU_BLOCK_DIM, LRU_BLOCK_DIM), LRU_BLOCK_DIM ** -0.5),
        'lru_ba': nrm(ks[6], (L, LRU_WIDTH), 0.01),
        'lru_wx': nrm(ks[7], (L, LRU_BLOCKS, LRU_BLOCK_DIM, LRU_BLOCK_DIM), LRU_BLOCK_DIM ** -0.5),
        'lru_bx': nrm(ks[8], (L, LRU_WIDTH), 0.01),
        'lru_lambda': jnp.log(a0) - jnp.log1p(-a0),
        'cmp_pos_k': nrm(ks[10], (L, CMP_BLOCK, HEAD_DIM), 0.02),
        'cmpk_w1': nrm(ks[11], (L, fan_c, HEAD_DIM), fan_c ** -0.5),
        'cmpk_b1': nrm(ks[12], (L, HEAD_DIM), 0.01),
        'cmpk_w2': nrm(ks[13], (L, HEAD_DIM, HEAD_DIM), HEAD_DIM ** -0.5),
        'cmpk_b2': nrm(ks[14], (L, HEAD_DIM), 0.01),
        'cmp_pos_v': nrm(ks[15], (L, CMP_BLOCK, HEAD_DIM), 0.02),
        'cmpv_w1': nrm(ks[16], (L, fan_c, HEAD_DIM), fan_c ** -0.5),
        'cmpv_b1': nrm(ks[17], (L, HEAD_DIM), 0.01),
        'cmpv_w2': nrm(ks[18], (L, HEAD_DIM, HEAD_DIM), HEAD_DIM ** -0.5),
        'cmpv_b2': nrm(ks[19], (L, HEAD_DIM), 0.01),
        'gn_lru_g': 1.0 + nrm(ks[20], (L, LRU_WIDTH), 0.02),
        'gn_nsa_g': 1.0 + nrm(ks[21], (L, NSA_WIDTH), 0.02),
        'w_out': nrm(ks[22], (L, MIX_WIDTH, D_MODEL), BETA * MIX_WIDTH ** -0.5),
        'ln1_g': 1.0 + nrm(ks[23], (L, D_MODEL), 0.02),
        'ln1_b': nrm(ks[24], (L, D_MODEL), 0.02),
        'peer_wq': nrm(ks[25], (L, D_MODEL, PEER_HEADS * 2 * PEER_KEY_DIM), D_MODEL ** -0.5),
        'peer_subkeys': nrm(ks[26], (L, 2, PEER_KEYS, PEER_KEY_DIM), PEER_KEY_DIM ** -0.5),
        'peer_u': nrm(ks[27], (L, N_EXPERTS, D_MODEL), D_MODEL ** -0.5),
        'peer_v': nrm(ks[28], (L, N_EXPERTS, D_MODEL), BETA * PEER_HEADS ** -0.5),
        'ln2_g': 1.0 + nrm(ks[29], (L, D_MODEL), 0.02),
        'ln2_b': nrm(ks[30], (L, D_MODEL), 0.02),
    }


def reference(x, w_in, b_in, conv_w, conv_b, lru_wa, lru_ba, lru_wx, lru_bx, lru_lambda,
              cmp_pos_k, cmpk_w1, cmpk_b1, cmpk_w2, cmpk_b2,
              cmp_pos_v, cmpv_w1, cmpv_b1, cmpv_w2, cmpv_b2,
              gn_lru_g, gn_nsa_g, w_out, ln1_g, ln1_b,
              peer_wq, peer_subkeys, peer_u, peer_v, ln2_g, ln2_b):
    B, S, _ = x.shape
    offsets = np.cumsum(IN_SPLITS)[:-1].tolist()
    for l in range(DEPTH):
        h = x @ w_in[l] + b_in[l]
        lru_x, lru_gate, q, kc_raw, vc_raw, ks_, vs_, kw_, vw_, gts = jnp.split(h, offsets, axis=-1)
        y_lru = _rg_lru(lru_x, lru_gate, conv_w[l], conv_b[l], lru_wa[l], lru_ba[l],
                        lru_wx[l], lru_bx[l], lru_lambda[l])
        kv = lambda t: t.reshape(B, S, N_KV, HEAD_DIM)
        kc = _compress(kv(kc_raw), cmp_pos_k[l], cmpk_w1[l], cmpk_b1[l], cmpk_w2[l], cmpk_b2[l])
        vc = _compress(kv(vc_raw), cmp_pos_v[l], cmpv_w1[l], cmpv_b1[l], cmpv_w2[l], cmpv_b2[l])
        y_nsa = _nsa(q.reshape(B, S, N_HEADS, HEAD_DIM), kc, vc, kv(ks_), kv(vs_), kv(kw_), kv(vw_),
                     gts.reshape(B, S, N_HEADS, N_BRANCHES))
        mix = jnp.concatenate([_rms_norm(y_lru, gn_lru_g[l]), _rms_norm(y_nsa, gn_nsa_g[l])], axis=-1) @ w_out[l]
        x = _layer_norm(ALPHA * x + mix, ln1_g[l], ln1_b[l])
        x = _layer_norm(ALPHA * x + _peer(x, peer_wq[l], peer_subkeys[l], peer_u[l], peer_v[l]), ln2_g[l], ln2_b[l])
    return x
```

```cpp
#include <hip/hip_runtime.h>
#include <hip/hip_cooperative_groups.h>
#include <stdint.h>
#include <stdio.h>
namespace cg = cooperative_groups;

#ifndef ONE_LAUNCH
#define ONE_LAUNCH 1
#ifndef PROBE_DUP
#define PROBE_DUP -100
#endif
#endif

typedef unsigned short bf16_t;
typedef __attribute__((ext_vector_type(8))) short bf16x8;
typedef __attribute__((ext_vector_type(16))) float f32x16;
typedef __attribute__((ext_vector_type(4))) float f32x4;
typedef __bf16 bf16x2_t __attribute__((ext_vector_type(2)));

#define DEV __device__ __forceinline__

constexpr int T_TOK = 32768;
constexpr int SEQ = 4096;
constexpr int NIN = 2328;
constexpr int NINP = 2432;
constexpr int HS = 2072;
constexpr float ALPHA_C = 1.4142135623730951f;
constexpr float EPS_C = 1e-5f;
constexpr int NPHASE = 17;

struct Params {
  const float *x, *w_in, *b_in, *conv_w, *conv_b, *lru_wa, *lru_ba, *lru_wx, *lru_bx, *lru_lambda;
  const float *cmp_pos_k, *cmpk_w1, *cmpk_b1, *cmpk_w2, *cmpk_b2, *cmp_pos_v, *cmpv_w1, *cmpv_b1, *cmpv_w2, *cmpv_b2;
  const float *gn_lru_g, *gn_nsa_g, *w_out, *ln1_g, *ln1_b, *peer_wq, *peer_subkeys, *peer_u, *peer_v, *ln2_g, *ln2_b;
  float* out;
  bf16_t *WinT, *WoutT, *WqT, *SK, *W1T, *KC, *VCT, *VsT, *VwT, *H, *XB, *CAT, *HL, *PB, *QP, *WgT, *MIX;
  unsigned char *U8, *V8;
  float *SU, *SV;
  float *AP, *HE, *GATE;
  int* EXP;
  unsigned* bar;
};

DEV int opaque_tid() { int t = (int)threadIdx.x; asm volatile("" : "+v"(t)); return t; }
typedef float f32x2 __attribute__((ext_vector_type(2)));
DEV unsigned pack2(float a, float b) {
  const f32x2 v = {a, b};
  return __builtin_bit_cast(unsigned, __builtin_convertvector(v, bf16x2_t));
}
DEV unsigned short f2bf(float f) { return (unsigned short)(pack2(f, 0.f) & 0xFFFFu); }
DEV float bf2f(unsigned short h) { return __uint_as_float(((unsigned)h) << 16); }
DEV float lo_f(unsigned w) { return __uint_as_float(w << 16); }
DEV float hi_f(unsigned w) { return __uint_as_float(w & 0xFFFF0000u); }
DEV f32x16 mfma32(bf16x8 a, bf16x8 b, f32x16 c) { return __builtin_amdgcn_mfma_f32_32x32x16_bf16(a, b, c, 0, 0, 0); }
DEV f32x4 mfma16(bf16x8 a, bf16x8 b, f32x4 c) { return __builtin_amdgcn_mfma_f32_16x16x32_bf16(a, b, c, 0, 0, 0); }
DEV float gelu_t(float x) {
  float z = 0.7978845608028654f * (x + 0.044715f * x * x * x);
  float e = __expf(2.f * z);
  float th = 1.f - 2.f / (e + 1.f);
  return 0.5f * x * (1.f + th);
}
DEV float sigmoid_f(float x) { return 1.f / (1.f + __expf(-x)); }
DEV float dpp_row_shr(float v, int n) {
  const int iv = __builtin_bit_cast(int, v); int r;
  switch (n) { case 1: r = __builtin_amdgcn_update_dpp(0, iv, 0x111, 0xf, 0xf, true); break; case 2: r = __builtin_amdgcn_update_dpp(0, iv, 0x112, 0xf, 0xf, true); break;
               case 4: r = __builtin_amdgcn_update_dpp(0, iv, 0x114, 0xf, 0xf, true); break; default: r = __builtin_amdgcn_update_dpp(0, iv, 0x118, 0xf, 0xf, true); break; }
  return __builtin_bit_cast(float, r);
}
DEV float wave_sum(float v) {
  v += dpp_row_shr(v, 1); v += dpp_row_shr(v, 2); v += dpp_row_shr(v, 4); v += dpp_row_shr(v, 8);
  v += __builtin_bit_cast(float, __builtin_amdgcn_update_dpp(0, __builtin_bit_cast(int, v), 0x142, 0xa, 0xf, false));
  v += __builtin_bit_cast(float, __builtin_amdgcn_update_dpp(0, __builtin_bit_cast(int, v), 0x143, 0xc, 0xf, false));
  return __builtin_bit_cast(float, __builtin_amdgcn_readlane(__builtin_bit_cast(int, v), 63));
}
DEV float xor32_f(float v) { return __shfl_xor(v, 32, 64); }
DEV unsigned xor32_u(unsigned v) { return (unsigned)__shfl_xor((int)v, 32, 64); }
DEV bf16x8 pack8(const float* p) {
  uint4 o; o.x = pack2(p[0], p[1]); o.y = pack2(p[2], p[3]); o.z = pack2(p[4], p[5]); o.w = pack2(p[6], p[7]);
  return __builtin_bit_cast(bf16x8, o);
}

__device__ void cvt_job(const float* __restrict__ src, bf16_t* __restrict__ dst, size_t n8, size_t gtid, size_t gsz) {
  for (size_t i = gtid; i < n8; i += gsz) {
    float4 a = ((const float4*)src)[2 * i], b = ((const float4*)src)[2 * i + 1];
    uint4 o; o.x = pack2(a.x, a.y); o.y = pack2(a.z, a.w); o.z = pack2(b.x, b.y); o.w = pack2(b.z, b.w);
    ((uint4*)dst)[i] = o;
  }
}
__device__ void tr_job(const float* __restrict__ src, bf16_t* __restrict__ dst, int K, int Nsrc, int Npad, size_t gtid, size_t gsz) {
  const size_t total = (size_t)Npad * (size_t)(K / 8);
  for (size_t i = gtid; i < total; i += gsz) {
    const int n = (int)(i % (size_t)Npad); const int k8 = (int)(i / (size_t)Npad);
    float v[8];
#pragma unroll
    for (int j = 0; j < 8; ++j) v[j] = (n < Nsrc) ? src[(size_t)(k8 * 8 + j) * Nsrc + n] : 0.f;
    uint4 o; o.x = pack2(v[0], v[1]); o.y = pack2(v[2], v[3]); o.z = pack2(v[4], v[5]); o.w = pack2(v[6], v[7]);
    *(uint4*)(dst + (size_t)n * K + k8 * 8) = o;
  }
}

__device__ void quant_rows(const float* __restrict__ src, unsigned char* __restrict__ dst, float* __restrict__ scl, int nrows) {
  const int tid = opaque_tid(), lane = tid & 63, w = tid >> 6;
  for (int r = blockIdx.x * 4 + w; r < nrows; r += gridDim.x * 4) {
    const float4* p = (const float4*)(src + (size_t)r * 1024 + lane * 16);
    const float4 a = p[0], b = p[1], c = p[2], d = p[3];
    float m = fmaxf(fmaxf(fmaxf(fabsf(a.x), fabsf(a.y)), fmaxf(fabsf(a.z), fabsf(a.w))), fmaxf(fmaxf(fabsf(b.x), fabsf(b.y)), fmaxf(fabsf(b.z), fabsf(b.w))));
    m = fmaxf(m, fmaxf(fmaxf(fmaxf(fabsf(c.x), fabsf(c.y)), fmaxf(fabsf(c.z), fabsf(c.w))), fmaxf(fmaxf(fabsf(d.x), fabsf(d.y)), fmaxf(fabsf(d.z), fabsf(d.w)))));
#pragma unroll
    for (int o = 1; o < 64; o <<= 1) m = fmaxf(m, __shfl_xor(m, o, 64));
    const float sc = (m > 0.f) ? m * (1.f / 256.f) : 1.f;
    const float inv = 1.f / sc;
    uint4 o4; int t;
    t = __builtin_amdgcn_cvt_pk_fp8_f32(a.x * inv, a.y * inv, 0, false); t = __builtin_amdgcn_cvt_pk_fp8_f32(a.z * inv, a.w * inv, t, true); o4.x = (unsigned)t;
    t = __builtin_amdgcn_cvt_pk_fp8_f32(b.x * inv, b.y * inv, 0, false); t = __builtin_amdgcn_cvt_pk_fp8_f32(b.z * inv, b.w * inv, t, true); o4.y = (unsigned)t;
    t = __builtin_amdgcn_cvt_pk_fp8_f32(c.x * inv, c.y * inv, 0, false); t = __builtin_amdgcn_cvt_pk_fp8_f32(c.z * inv, c.w * inv, t, true); o4.z = (unsigned)t;
    t = __builtin_amdgcn_cvt_pk_fp8_f32(d.x * inv, d.y * inv, 0, false); t = __builtin_amdgcn_cvt_pk_fp8_f32(d.z * inv, d.w * inv, t, true); o4.w = (unsigned)t;
    *(uint4*)(dst + (size_t)r * 1024 + lane * 16) = o4;
    if (lane == 0) scl[r] = sc;
  }
}
typedef unsigned v6u_t __attribute__((ext_vector_type(6)));
typedef float v32f_t __attribute__((ext_vector_type(32)));
typedef __bf16 v32bf_t __attribute__((ext_vector_type(32)));
__device__ void quant_rows_fp6(const float* __restrict__ src, unsigned char* __restrict__ dst, float* __restrict__ scl, int nrows) {
  const int tid = opaque_tid(), lane = tid & 63, w = tid >> 6;
  const int l32 = lane & 31, hf = lane >> 5;
  for (int rp = blockIdx.x * 4 + w; rp < nrows / 2; rp += gridDim.x * 4) {
    const int r = rp * 2 + hf;
    const float4* p = (const float4*)(src + (size_t)r * 1024 + l32 * 32);
    float v[32];
#pragma unroll
    for (int i = 0; i < 8; ++i) { const float4 t = p[i]; v[4 * i] = t.x; v[4 * i + 1] = t.y; v[4 * i + 2] = t.z; v[4 * i + 3] = t.w; }
    float m = 0.f;
#pragma unroll
    for (int i = 0; i < 32; ++i) m = fmaxf(m, fabsf(v[i]));
#pragma unroll
    for (int o = 1; o < 32; o <<= 1) m = fmaxf(m, __shfl_xor(m, o, 64));
    const float sc = (m > 0.f) ? m * (1.f / 7.5f) : 1.f;
    const float inv = 1.f / sc;
    v32bf_t bv;
#pragma unroll
    for (int i = 0; i < 32; ++i) bv[i] = (__bf16)(v[i] * inv);
    const v6u_t qv = __builtin_amdgcn_cvt_scalef32_pk32_fp6_bf16(bv, 1.0f);
    uint2* o2 = (uint2*)(dst + (size_t)r * 768 + l32 * 24);
    uint2 t0, t1, t2; t0.x = qv[0]; t0.y = qv[1]; t1.x = qv[2]; t1.y = qv[3]; t2.x = qv[4]; t2.y = qv[5];
    o2[0] = t0; o2[1] = t1; o2[2] = t2;
    if (l32 == 0) scl[r] = sc;
  }
}
__device__ void quant_rows_fp4(const float* __restrict__ src, unsigned char* __restrict__ dst, float* __restrict__ scl, int nrows) {
  const int tid = opaque_tid(), lane = tid & 63, w = tid >> 6;
  for (int r = blockIdx.x * 4 + w; r < nrows; r += gridDim.x * 4) {
    const float4* p = (const float4*)(src + (size_t)r * 1024 + lane * 16);
    const float4 a = p[0], b = p[1], c = p[2], d = p[3];
    float m = fmaxf(fmaxf(fmaxf(fabsf(a.x), fabsf(a.y)), fmaxf(fabsf(a.z), fabsf(a.w))), fmaxf(fmaxf(fabsf(b.x), fabsf(b.y)), fmaxf(fabsf(b.z), fabsf(b.w))));
    m = fmaxf(m, fmaxf(fmaxf(fmaxf(fabsf(c.x), fabsf(c.y)), fmaxf(fabsf(c.z), fabsf(c.w))), fmaxf(fmaxf(fabsf(d.x), fabsf(d.y)), fmaxf(fabsf(d.z), fabsf(d.w)))));
#pragma unroll
    for (int o = 1; o < 64; o <<= 1) m = fmaxf(m, __shfl_xor(m, o, 64));
    const float sc = (m > 0.f) ? m * (1.f / 6.f) : 1.f;
    const float inv = 1.f / sc;
    unsigned q0 = 0u, q1 = 0u;
    q0 = __builtin_amdgcn_cvt_scalef32_pk_fp4_f32(q0, a.x * inv, a.y * inv, 1.0f, 0);
    q0 = __builtin_amdgcn_cvt_scalef32_pk_fp4_f32(q0, a.z * inv, a.w * inv, 1.0f, 1);
    q0 = __builtin_amdgcn_cvt_scalef32_pk_fp4_f32(q0, b.x * inv, b.y * inv, 1.0f, 2);
    q0 = __builtin_amdgcn_cvt_scalef32_pk_fp4_f32(q0, b.z * inv, b.w * inv, 1.0f, 3);
    q1 = __builtin_amdgcn_cvt_scalef32_pk_fp4_f32(q1, c.x * inv, c.y * inv, 1.0f, 0);
    q1 = __builtin_amdgcn_cvt_scalef32_pk_fp4_f32(q1, c.z * inv, c.w * inv, 1.0f, 1);
    q1 = __builtin_amdgcn_cvt_scalef32_pk_fp4_f32(q1, d.x * inv, d.y * inv, 1.0f, 2);
    q1 = __builtin_amdgcn_cvt_scalef32_pk_fp4_f32(q1, d.z * inv, d.w * inv, 1.0f, 3);
    uint2 o2; o2.x = q0; o2.y = q1;
    *(uint2*)(dst + (size_t)r * 512 + lane * 8) = o2;
    if (lane == 0) scl[r] = sc;
  }
}
__device__ void phase_prologue(const Params& P) {
  const size_t gtid = (size_t)blockIdx.x * 256 + opaque_tid(), gsz = (size_t)gridDim.x * 256;
  cvt_job(P.x, P.XB, (size_t)T_TOK * 1024 / 8, gtid, gsz);
  quant_rows_fp6(P.peer_u, P.U8, P.SU, 2 * 16384);
  quant_rows_fp4(P.peer_v, P.V8, P.SV, 2 * 16384);
  cvt_job(P.peer_subkeys, P.SK, (size_t)2 * 2 * 128 * 128 / 8, gtid, gsz);
  for (int l = 0; l < 2; ++l) {
    tr_job(P.w_in + (size_t)l * 1024 * NIN, P.WinT + (size_t)l * NINP * 1024, 1024, NIN, NINP, gtid, gsz);
    tr_job(P.w_out + (size_t)l * 1024 * 1024, P.WoutT + (size_t)l * 1024 * 1024, 1024, 1024, 1024, gtid, gsz);
    tr_job(P.peer_wq + (size_t)l * 1024 * 2048, P.WqT + (size_t)l * 2048 * 1024, 1024, 2048, 2048, gtid, gsz);
    tr_job(P.cmpk_w1 + (size_t)l * 2048 * 64, P.W1T + (size_t)(l * 2 + 0) * 64 * 2048, 2048, 64, 64, gtid, gsz);
    tr_job(P.cmpv_w1 + (size_t)l * 2048 * 64, P.W1T + (size_t)(l * 2 + 1) * 64 * 2048, 2048, 64, 64, gtid, gsz);
  }
  for (size_t i = gtid; i < (size_t)2 * 8 * 2 * 64 * 8; i += gsz) {
    const int d8 = (int)(i & 7), e = (int)((i >> 3) & 63), mat = (int)((i >> 9) & 1), n = (int)((i >> 10) & 7), l = (int)(i >> 13);
    const float* src = (mat ? P.lru_wx : P.lru_wa) + (size_t)(l * 8 + n) * 4096 + e;
    float v[8];
#pragma unroll
    for (int k = 0; k < 8; ++k) v[k] = src[(size_t)(d8 * 8 + k) * 64];
    uint4 o; o.x = pack2(v[0], v[1]); o.y = pack2(v[2], v[3]); o.z = pack2(v[4], v[5]); o.w = pack2(v[6], v[7]);
    *(uint4*)(P.WgT + ((size_t)((l * 8 + n) * 2 + mat) * 64 + e) * 64 + d8 * 8) = o;
  }
  {
    const size_t n16 = (size_t)2 * 8 * 2 * 256 * 64 * 2 / 16;
    uint4 z; z.x = z.y = z.z = z.w = 0u;
    for (size_t i = gtid; i < n16; i += gsz) ((uint4*)P.KC)[i] = z;
  }
}

DEV void gemm_core(const bf16_t* __restrict__ A, const bf16_t* __restrict__ Bt, int m0, int n0, bf16_t* As, bf16_t* Bs, int tid,
                   f32x16 (&acc)[2][2]) {
  const int lane = tid & 63, w = tid >> 6;
  const int wm = w >> 1, wn = w & 1, lr = lane & 31, hk = lane >> 5;
#pragma unroll
  for (int a = 0; a < 2; ++a)
#pragma unroll
    for (int b = 0; b < 2; ++b)
#pragma unroll
      for (int i = 0; i < 16; ++i) acc[a][b][i] = 0.f;
  uint4 ra0, ra1, ra2, ra3, rb0, rb1, rb2, rb3;
  const int lrow = tid >> 3, lc8 = (tid & 7) * 8;
  const bf16_t* Ap = A + (size_t)(m0 + lrow) * 1024 + lc8;
  const bf16_t* Bp = Bt + (size_t)(n0 + lrow) * 1024 + lc8;
#define GLOAD(k0) { ra0 = *(const uint4*)(Ap + (k0)); ra1 = *(const uint4*)(Ap + 32 * 1024 + (k0)); ra2 = *(const uint4*)(Ap + 64 * 1024 + (k0)); ra3 = *(const uint4*)(Ap + 96 * 1024 + (k0)); \
                    rb0 = *(const uint4*)(Bp + (k0)); rb1 = *(const uint4*)(Bp + 32 * 1024 + (k0)); rb2 = *(const uint4*)(Bp + 64 * 1024 + (k0)); rb3 = *(const uint4*)(Bp + 96 * 1024 + (k0)); }
  GLOAD(0);
  for (int kt = 0; kt < 16; ++kt) {
    __syncthreads();
    {
      bf16_t* as = As + lrow * 72 + lc8; bf16_t* bs = Bs + lrow * 72 + lc8;
      *(uint4*)(as) = ra0; *(uint4*)(as + 32 * 72) = ra1; *(uint4*)(as + 64 * 72) = ra2; *(uint4*)(as + 96 * 72) = ra3;
      *(uint4*)(bs) = rb0; *(uint4*)(bs + 32 * 72) = rb1; *(uint4*)(bs + 64 * 72) = rb2; *(uint4*)(bs + 96 * 72) = rb3;
    }
    __syncthreads();
    {
      const int k0 = (kt + 1 < 16) ? (kt + 1) * 64 : 15 * 64;
      GLOAD(k0);
    }
#pragma unroll
    for (int kk = 0; kk < 4; ++kk) {
      bf16x8 af[2], bfr[2];
#pragma unroll
      for (int mi = 0; mi < 2; ++mi) af[mi] = *(const bf16x8*)(As + (wm * 64 + mi * 32 + lr) * 72 + kk * 16 + hk * 8);
#pragma unroll
      for (int ni = 0; ni < 2; ++ni) bfr[ni] = *(const bf16x8*)(Bs + (wn * 64 + ni * 32 + lr) * 72 + kk * 16 + hk * 8);
#pragma unroll
      for (int mi = 0; mi < 2; ++mi)
#pragma unroll
        for (int ni = 0; ni < 2; ++ni) acc[mi][ni] = mfma32(af[mi], bfr[ni], acc[mi][ni]);
    }
  }
#undef GLOAD
}

template <int EPI>
__device__ void gemm_phase(const Params& P, int l, const bf16_t* __restrict__ A, const bf16_t* __restrict__ Bt, int NT, char* smem) {
  bf16_t* As = (bf16_t*)smem;
  bf16_t* Bs = As + 128 * 72;
  const int tid = opaque_tid(), lane = tid & 63, w = tid >> 6;
  const int wm = w >> 1, wn = w & 1, lr = lane & 31, hk = lane >> 5;
  const int ntiles = 256 * NT;
  for (int tile = blockIdx.x; tile < ntiles; tile += gridDim.x) {
    const int mt = tile / NT, nt = tile - mt * NT;
    const int m0 = mt * 128, n0 = nt * 128;
    f32x16 acc[2][2];
    gemm_core(A, Bt, m0, n0, As, Bs, tid, acc);
#pragma unroll
    for (int mi = 0; mi < 2; ++mi)
#pragma unroll
      for (int ni = 0; ni < 2; ++ni) {
        const int n = n0 + wn * 64 + ni * 32 + lr;
        const int mbase = m0 + wm * 64 + mi * 32 + 4 * hk;
        if (EPI == 0) {
          if (nt == 15 || nt == 17) {
            bf16_t* VT = (nt == 15) ? P.VsT : P.VwT;
            const int nl = n - n0, g = nl >> 6, d = nl & 63;
            const float bias = P.b_in[l * NIN + n];
#pragma unroll
            for (int i4 = 0; i4 < 4; ++i4) {
              const int m = mbase + 8 * i4;
              const int b = m >> 12, s = m & 4095;
              uint2 o;
              o.x = pack2(acc[mi][ni][4 * i4 + 0] + bias, acc[mi][ni][4 * i4 + 1] + bias);
              o.y = pack2(acc[mi][ni][4 * i4 + 2] + bias, acc[mi][ni][4 * i4 + 3] + bias);
              *(uint2*)(VT + ((size_t)((b * 2 + g) * 64 + d)) * 4096 + s) = o;
            }
          } else if (n < NIN) {
            const int hcol = n - (nt == 16 ? 128 : (nt == 18 ? 256 : 0));
            const float bias = P.b_in[l * NIN + n];
#pragma unroll
            for (int i = 0; i < 16; ++i) {
              const int m = mbase + (i & 3) + 8 * (i >> 2);
              P.H[(size_t)m * HS + hcol] = f2bf(acc[mi][ni][i] + bias);
            }
          }
        } else if (EPI == 1) {
#pragma unroll
          for (int i = 0; i < 16; ++i) {
            const int m = mbase + (i & 3) + 8 * (i >> 2);
            P.MIX[(size_t)m * 1024 + n] = f2bf(acc[mi][ni][i]);
          }
        } else {
#pragma unroll
          for (int i = 0; i < 16; ++i) {
            const int m = mbase + (i & 3) + 8 * (i >> 2);
            P.QP[(size_t)m * 2048 + n] = f2bf(acc[mi][ni][i]);
          }
        }
      }
  }
}


template <int EPI>
__device__ void gemm_phase256(const Params& P, int l, const bf16_t* __restrict__ A, const bf16_t* __restrict__ Bt, int NT, char* smem) {
  bf16_t* As = (bf16_t*)smem;
  bf16_t* Bs = As + 256 * 72;
  const int tid = opaque_tid(), lane = tid & 63, w = tid >> 6;
  const int wm = w >> 1, wn = w & 1, lr = lane & 31, hk = lane >> 5;
  const int xcd = blockIdx.x & 7, lb = blockIdx.x >> 3, nbx = ((int)gridDim.x - xcd + 7) >> 3;
  const int nloc = 16 * NT;
  for (int lt = lb; lt < nloc; lt += nbx) {
    const int mtl = lt / NT, nt = lt - mtl * NT;
    const int mt = xcd * 16 + mtl;
    const int m0 = mt * 256, n0 = nt * 128;
    f32x16 acc[4][2];
#pragma unroll
    for (int a = 0; a < 4; ++a)
#pragma unroll
      for (int b = 0; b < 2; ++b)
#pragma unroll
        for (int i = 0; i < 16; ++i) acc[a][b][i] = 0.f;
    uint4 ra0, ra1, ra2, ra3, ra4, ra5, ra6, ra7, rb0, rb1, rb2, rb3;
    const int lrow = tid >> 3, lc8 = (tid & 7) * 8;
    const bf16_t* Ap = A + (size_t)(m0 + lrow) * 1024 + lc8;
    const bf16_t* Bp = Bt + (size_t)(n0 + lrow) * 1024 + lc8;
#define GLOAD2(k0) { ra0 = *(const uint4*)(Ap + (k0)); ra1 = *(const uint4*)(Ap + 32 * 1024 + (k0)); ra2 = *(const uint4*)(Ap + 64 * 1024 + (k0)); ra3 = *(const uint4*)(Ap + 96 * 1024 + (k0)); \
                     ra4 = *(const uint4*)(Ap + 128 * 1024 + (k0)); ra5 = *(const uint4*)(Ap + 160 * 1024 + (k0)); ra6 = *(const uint4*)(Ap + 192 * 1024 + (k0)); ra7 = *(const uint4*)(Ap + 224 * 1024 + (k0)); \
                     rb0 = *(const uint4*)(Bp + (k0)); rb1 = *(const uint4*)(Bp + 32 * 1024 + (k0)); rb2 = *(const uint4*)(Bp + 64 * 1024 + (k0)); rb3 = *(const uint4*)(Bp + 96 * 1024 + (k0)); }
    GLOAD2(0);
    for (int kt = 0; kt < 16; ++kt) {
      __syncthreads();
      {
        bf16_t* as = As + lrow * 72 + lc8; bf16_t* bs = Bs + lrow * 72 + lc8;
        *(uint4*)(as) = ra0; *(uint4*)(as + 32 * 72) = ra1; *(uint4*)(as + 64 * 72) = ra2; *(uint4*)(as + 96 * 72) = ra3;
        *(uint4*)(as + 128 * 72) = ra4; *(uint4*)(as + 160 * 72) = ra5; *(uint4*)(as + 192 * 72) = ra6; *(uint4*)(as + 224 * 72) = ra7;
        *(uint4*)(bs) = rb0; *(uint4*)(bs + 32 * 72) = rb1; *(uint4*)(bs + 64 * 72) = rb2; *(uint4*)(bs + 96 * 72) = rb3;
      }
      __syncthreads();
      {
        const int k0 = (kt + 1 < 16) ? (kt + 1) * 64 : 15 * 64;
        GLOAD2(k0);
      }
      __builtin_amdgcn_sched_barrier(0);
#pragma unroll
      for (int kk = 0; kk < 4; ++kk) {
        bf16x8 af[4], bfr[2];
#pragma unroll
        for (int mi = 0; mi < 4; ++mi) af[mi] = *(const bf16x8*)(As + (wm * 128 + mi * 32 + lr) * 72 + kk * 16 + hk * 8);
#pragma unroll
        for (int ni = 0; ni < 2; ++ni) bfr[ni] = *(const bf16x8*)(Bs + (wn * 64 + ni * 32 + lr) * 72 + kk * 16 + hk * 8);
#pragma unroll
        for (int mi = 0; mi < 4; ++mi)
#pragma unroll
          for (int ni = 0; ni < 2; ++ni) acc[mi][ni] = mfma32(af[mi], bfr[ni], acc[mi][ni]);
      }
    }
#undef GLOAD2
    __syncthreads();
    bf16_t* Cs = (bf16_t*)smem;
    const bool vt_tile = (EPI == 0) && (nt == 15 || nt == 17);
    if (vt_tile) {
#pragma unroll
      for (int mi = 0; mi < 4; ++mi)
#pragma unroll
        for (int ni = 0; ni < 2; ++ni) {
          const int d = wn * 64 + ni * 32 + lr;
          const float bias = P.b_in[l * NIN + n0 + d];
          const int rb = wm * 128 + mi * 32 + 4 * hk;
#pragma unroll
          for (int i4 = 0; i4 < 4; ++i4) {
            uint2 o;
            o.x = pack2(acc[mi][ni][4 * i4 + 0] + bias, acc[mi][ni][4 * i4 + 1] + bias);
            o.y = pack2(acc[mi][ni][4 * i4 + 2] + bias, acc[mi][ni][4 * i4 + 3] + bias);
            *(uint2*)(Cs + d * 264 + rb + 8 * i4) = o;
          }
        }
      __syncthreads();
      bf16_t* VT = (nt == 15) ? P.VsT : P.VwT;
      const int bb = m0 >> 12, s0 = m0 & 4095;
#pragma unroll 4
      for (int k = 0; k < 16; ++k) {
        const int c = tid + 256 * k;
        const int d = c >> 5, c8 = (c & 31) * 8;
        const uint4 v = *(const uint4*)(Cs + d * 264 + c8);
        *(uint4*)(VT + ((size_t)((bb * 2 + (d >> 6)) * 64 + (d & 63))) * 4096 + s0 + c8) = v;
      }
    } else {
#pragma unroll
      for (int mi = 0; mi < 4; ++mi)
#pragma unroll
        for (int ni = 0; ni < 2; ++ni) {
          const int col = wn * 64 + ni * 32 + lr;
          const int n = n0 + col;
          const float bias = (EPI == 0) ? ((n < NIN) ? P.b_in[l * NIN + n] : 0.f) : 0.f;
          const int rb = wm * 128 + mi * 32 + 4 * hk;
#pragma unroll
          for (int i = 0; i < 16; ++i) Cs[(rb + (i & 3) + 8 * (i >> 2)) * 136 + col] = f2bf(acc[mi][ni][i] + bias);
        }
      __syncthreads();
      bf16_t* dstb; int dstride, cbase, nvalid;
      if (EPI == 0) { dstb = P.H; dstride = HS; cbase = n0 - (nt == 16 ? 128 : (nt == 18 ? 256 : 0)); nvalid = (NIN - n0 < 128) ? (NIN - n0) : 128; }
      else { dstb = P.MIX; dstride = 1024; cbase = n0; nvalid = 128; }
#pragma unroll 4
      for (int k = 0; k < 16; ++k) {
        const int c = tid + 256 * k;
        const int row = c >> 4, c8 = (c & 15) * 8;
        if (c8 < nvalid) {
          const uint4 v = *(const uint4*)(Cs + row * 136 + c8);
          *(uint4*)(dstb + (size_t)(m0 + row) * dstride + cbase + c8) = v;
        }
      }
    }
  }
}

__device__ void lru_local_item(const Params& P, int l, int item, char* smem) {
  float* xs = (float*)smem;
  bf16_t* xb = (bf16_t*)(smem + 16384);
  const int tid = opaque_tid(), lane = tid & 63, w = tid >> 6;
  float* cs = (float*)(smem + 25088) + w * 2048;
  const int half = item & 1, j = (item >> 1) & 63, b = item >> 7;
  const int ch = half * 256 + tid, n = ch >> 6;
  const int r16 = lane & 15, kq = lane >> 4;
  bf16x8 bw[2][4][2];
  {
    const bf16_t* wt = P.WgT + (size_t)(l * 8 + n) * 2 * 4096;
#pragma unroll
    for (int mat = 0; mat < 2; ++mat)
#pragma unroll
      for (int nt = 0; nt < 4; ++nt)
#pragma unroll
        for (int ks = 0; ks < 2; ++ks) bw[mat][nt][ks] = *(const bf16x8*)(wt + mat * 4096 + (nt * 16 + r16) * 64 + ks * 32 + kq * 8);
  }
  const float cw0 = P.conv_w[l * 4 * 512 + 0 * 512 + ch], cw1 = P.conv_w[l * 4 * 512 + 1 * 512 + ch];
  const float cw2 = P.conv_w[l * 4 * 512 + 2 * 512 + ch], cw3 = P.conv_w[l * 4 * 512 + 3 * 512 + ch];
  const float cb = P.conv_b[l * 512 + ch], ba = P.lru_ba[l * 512 + ch], bx = P.lru_bx[l * 512 + ch];
  const float lam = P.lru_lambda[l * 512 + ch];
  const float z = -lam;
  const float sp = fmaxf(z, 0.f) + log1pf(__expf(-fabsf(z)));
  const float nl = -8.0f * sp;
  const int s0 = j * 64;
  const bf16_t* hx = P.H + (size_t)(b * SEQ) * HS + ch;
  float xm3 = (s0 - 3 >= 0) ? bf2f(hx[(size_t)(s0 - 3) * HS]) : 0.f;
  float xm2 = (s0 - 2 >= 0) ? bf2f(hx[(size_t)(s0 - 2) * HS]) : 0.f;
  float xm1 = (s0 - 1 >= 0) ? bf2f(hx[(size_t)(s0 - 1) * HS]) : 0.f;
  float h = 0.f, pc = 1.f;
  unsigned short hv[16], hn[16];
#pragma unroll
  for (int i = 0; i < 16; ++i) { hv[i] = hx[(size_t)(s0 + i) * HS]; hn[i] = hv[i]; }
#pragma unroll 1
  for (int sub = 0; sub < 4; ++sub) {
    __syncthreads();
#pragma unroll
    for (int i = 0; i < 16; ++i) {
      const float xv = bf2f(hv[i]);
      const float xc = cb + cw0 * xm3 + cw1 * xm2 + cw2 * xm1 + cw3 * xv;
      xm3 = xm2; xm2 = xm1; xm1 = xv;
      xs[i * 256 + tid] = xc;
      xb[i * 264 + tid] = f2bf(xc);
    }
    __syncthreads();
    {
      bf16x8 af[2];
#pragma unroll
      for (int ks = 0; ks < 2; ++ks) af[ks] = *(const bf16x8*)(xb + r16 * 264 + w * 64 + ks * 32 + kq * 8);
#pragma unroll
      for (int mat = 0; mat < 2; ++mat)
#pragma unroll
        for (int nt = 0; nt < 4; ++nt) {
          f32x4 acc = {0.f, 0.f, 0.f, 0.f};
          acc = mfma16(af[0], bw[mat][nt][0], acc);
          acc = mfma16(af[1], bw[mat][nt][1], acc);
#pragma unroll
          for (int r = 0; r < 4; ++r) cs[mat * 1024 + (kq * 4 + r) * 64 + nt * 16 + r16] = acc[r];
        }
    }
    {
      const int sn = s0 + ((sub < 3) ? (sub + 1) * 16 : sub * 16);
#pragma unroll
      for (int i = 0; i < 16; ++i) hn[i] = hx[(size_t)(sn + i) * HS];
    }
    __syncthreads();
#pragma unroll 4
    for (int i = 0; i < 16; ++i) {
      const int s = s0 + sub * 16 + i;
      const float ra = cs[i * 64 + lane] + ba, ri = cs[1024 + i * 64 + lane] + bx;
      const float r = sigmoid_f(ra), ig = sigmoid_f(ri);
      const float la = r * nl;
      const float a = __expf(la);
      const float uu = sqrtf(fmaxf(1.f - a * a, 0.f)) * (ig * xs[i * 256 + tid]);
      h = a * h + uu; pc *= a;
      const size_t o = (size_t)(b * SEQ + s) * 512 + ch;
      P.HL[o] = f2bf(h); P.PB[o] = f2bf(pc);
    }
#pragma unroll
    for (int i = 0; i < 16; ++i) hv[i] = hn[i];
  }
  P.AP[(size_t)(b * 64 + j) * 512 + ch] = pc;
  P.HE[(size_t)(b * 64 + j) * 512 + ch] = h;
}

__device__ void compress_block_item(const Params& P, int l, int bitem, char* smem) {
  const int tid = opaque_tid(), lane = tid & 63, w = tid >> 6;
  float* part = (float*)smem;
  float* hid = (float*)smem + 4096;
  const int wi = bitem;
  const int rt = wi & 127, g = (wi >> 7) & 1, kv = wi >> 8;
  const int r16 = lane & 15, kq = lane >> 4;
  const int row = rt * 16 + r16, rowc = row < 2040 ? row : 2039;
  const int b = rowc / 255, n = rowc - b * 255;
  const bf16_t* src = P.H + (size_t)(b * SEQ + n * 16) * HS + (kv ? 1664 : 1536) + g * 64;
  const float* pos = (kv ? P.cmp_pos_v : P.cmp_pos_k) + l * 32 * 64;
  const bf16_t* W1T = P.W1T + (size_t)(l * 2 + kv) * 64 * 2048;
  f32x4 acc[4];
#pragma unroll
  for (int a = 0; a < 4; ++a) { acc[a][0] = 0.f; acc[a][1] = 0.f; acc[a][2] = 0.f; acc[a][3] = 0.f; }
#pragma unroll 4
  for (int k2 = 0; k2 < 16; ++k2) {
    const int ks = w * 16 + k2;
    const int tl = ks >> 1, d0 = (ks & 1) * 32 + kq * 8;
    const uint4 raw = *(const uint4*)(src + (size_t)tl * HS + d0);
    const float4 p0 = *(const float4*)(pos + tl * 64 + d0), p1 = *(const float4*)(pos + tl * 64 + d0 + 4);
    float v[8];
    v[0] = lo_f(raw.x) + p0.x; v[1] = hi_f(raw.x) + p0.y; v[2] = lo_f(raw.y) + p0.z; v[3] = hi_f(raw.y) + p0.w;
    v[4] = lo_f(raw.z) + p1.x; v[5] = hi_f(raw.z) + p1.y; v[6] = lo_f(raw.w) + p1.z; v[7] = hi_f(raw.w) + p1.w;
    const bf16x8 af = pack8(v);
#pragma unroll
    for (int nt = 0; nt < 4; ++nt) {
      const bf16x8 bfr = *(const bf16x8*)(W1T + (size_t)(nt * 16 + r16) * 2048 + ks * 32 + kq * 8);
      acc[nt] = mfma16(af, bfr, acc[nt]);
    }
  }
  const float* b1 = (kv ? P.cmpv_b1 : P.cmpk_b1) + l * 64;
  const float* w2 = (kv ? P.cmpv_w2 : P.cmpk_w2) + l * 64 * 64;
  const float* b2 = (kv ? P.cmpv_b2 : P.cmpk_b2) + l * 64;
  __syncthreads();
#pragma unroll
  for (int nt = 0; nt < 4; ++nt)
#pragma unroll
    for (int r = 0; r < 4; ++r) part[w * 1024 + (kq * 4 + r) * 64 + nt * 16 + r16] = acc[nt][r];
  __syncthreads();
#pragma unroll
  for (int k = 0; k < 4; ++k) {
    const int idx = tid + 256 * k;
    const float sum = part[idx] + part[1024 + idx] + part[2048 + idx] + part[3072 + idx];
    hid[idx] = gelu_t(sum + b1[idx & 63]);
  }
  __syncthreads();
  float w2c[64];
#pragma unroll
  for (int k = 0; k < 64; ++k) w2c[k] = w2[k * 64 + lane];
  const float bo = b2[lane];
#pragma unroll 1
  for (int r4 = 0; r4 < 4; ++r4) {
    const int rr = w * 4 + r4;
    float o = bo;
    const float4* hp = (const float4*)(hid + rr * 64);
#pragma unroll
    for (int k4 = 0; k4 < 16; ++k4) {
      const float4 hv = hp[k4];
      o += hv.x * w2c[4 * k4] + hv.y * w2c[4 * k4 + 1] + hv.z * w2c[4 * k4 + 2] + hv.w * w2c[4 * k4 + 3];
    }
    const int row2 = rt * 16 + rr;
    if (row2 < 2040) {
      const int b2i = row2 / 255, n2 = row2 - b2i * 255;
      if (kv == 0) P.KC[((size_t)((b2i * 2 + g) * 256 + n2)) * 64 + lane] = f2bf(o);
      else P.VCT[((size_t)((b2i * 2 + g) * 64 + lane)) * 256 + n2] = f2bf(o);
    }
  }
}

__device__ void lru_final_item(const Params& P, int l, int item) {
  const int tid = opaque_tid(), lane = tid & 63, w = tid >> 6;
  const int j = item & 63, b = item >> 6;
  float carry[8];
#pragma unroll
  for (int k = 0; k < 8; ++k) carry[k] = 0.f;
  for (int jj = 0; jj < j; ++jj) {
    const float* ap = P.AP + (size_t)(b * 64 + jj) * 512 + lane * 8;
    const float* he = P.HE + (size_t)(b * 64 + jj) * 512 + lane * 8;
    const float4 a0 = *(const float4*)ap, a1 = *(const float4*)(ap + 4);
    const float4 h0 = *(const float4*)he, h1 = *(const float4*)(he + 4);
    carry[0] = a0.x * carry[0] + h0.x; carry[1] = a0.y * carry[1] + h0.y; carry[2] = a0.z * carry[2] + h0.z; carry[3] = a0.w * carry[3] + h0.w;
    carry[4] = a1.x * carry[4] + h1.x; carry[5] = a1.y * carry[5] + h1.y; carry[6] = a1.z * carry[6] + h1.z; carry[7] = a1.w * carry[7] + h1.w;
  }
  const float* gg = P.gn_lru_g + l * 512 + lane * 8;
  const float4 g0 = *(const float4*)gg, g1 = *(const float4*)(gg + 4);
  const float gw[8] = {g0.x, g0.y, g0.z, g0.w, g1.x, g1.y, g1.z, g1.w};
  for (int i = 0; i < 16; ++i) {
    const int s = j * 64 + w + 4 * i;
    const size_t tok = (size_t)(b * SEQ + s);
    const uint4 hl = *(const uint4*)(P.HL + tok * 512 + lane * 8);
    const uint4 pb = *(const uint4*)(P.PB + tok * 512 + lane * 8);
    const uint4 gt = *(const uint4*)(P.H + tok * HS + 512 + lane * 8);
    const unsigned hw[4] = {hl.x, hl.y, hl.z, hl.w}, pw[4] = {pb.x, pb.y, pb.z, pb.w}, gx[4] = {gt.x, gt.y, gt.z, gt.w};
    float y[8]; float ss = 0.f;
#pragma unroll
    for (int k2 = 0; k2 < 4; ++k2) {
      const float h0 = lo_f(hw[k2]) + lo_f(pw[k2]) * carry[2 * k2];
      const float h1 = hi_f(hw[k2]) + hi_f(pw[k2]) * carry[2 * k2 + 1];
      y[2 * k2] = h0 * gelu_t(lo_f(gx[k2]));
      y[2 * k2 + 1] = h1 * gelu_t(hi_f(gx[k2]));
      ss += y[2 * k2] * y[2 * k2] + y[2 * k2 + 1] * y[2 * k2 + 1];
    }
    ss = wave_sum(ss);
    const float rs = rsqrtf(ss * (1.f / 512.f) + EPS_C);
    float o[8];
#pragma unroll
    for (int k = 0; k < 8; ++k) o[k] = y[k] * rs * gw[k];
    *(bf16x8*)(P.CAT + tok * 1024 + lane * 8) = pack8(o);
  }
}

DEV int kperm(int m) { return (m & 0x13) | ((m & 4) << 1) | ((m & 8) >> 1); }

struct AttAcc { f32x16 o0, o1; float m, l; };

DEV f32x16 qk_tile(const bf16_t* krow, const bf16x8 (&qf)[4]) {
  f32x16 s;
#pragma unroll
  for (int i = 0; i < 16; ++i) s[i] = 0.f;
#pragma unroll
  for (int ks = 0; ks < 4; ++ks) {
    const bf16x8 a = *(const bf16x8*)(krow + ks * 16);
    s = mfma32(a, qf[ks], s);
  }
  return s;
}
DEV void load_kfrag(bf16x8 (&kf)[4], const bf16_t* krow) {
#pragma unroll
  for (int ks = 0; ks < 4; ++ks) kf[ks] = *(const bf16x8*)(krow + ks * 16);
}
DEV f32x16 qk_regs(const bf16x8 (&kf)[4], const bf16x8 (&qf)[4]) {
  f32x16 s;
#pragma unroll
  for (int i = 0; i < 16; ++i) s[i] = 0.f;
#pragma unroll
  for (int ks = 0; ks < 4; ++ks) s = mfma32(kf[ks], qf[ks], s);
  return s;
}
DEV void pv_tile(f32x16& o0, f32x16& o1, const bf16_t* vt, size_t vstride, const float* p) {
  const bf16x8 pf0 = pack8(p), pf1 = pack8(p + 8);
  const bf16x8 a00 = *(const bf16x8*)(vt), a01 = *(const bf16x8*)(vt + 16);
  const bf16x8 a10 = *(const bf16x8*)(vt + 32 * vstride), a11 = *(const bf16x8*)(vt + 32 * vstride + 16);
  o0 = mfma32(a00, pf0, o0); o0 = mfma32(a01, pf1, o0);
  o1 = mfma32(a10, pf0, o1); o1 = mfma32(a11, pf1, o1);
}
DEV void att_tile(AttAcc& A, const f32x16& s, float qs, float slope2, int dt, float lane_bias, bool masked, int wlim,
                  const bf16_t* vt, size_t vstride) {
  const float sb = slope2 * (float)dt + lane_bias;
  float sc[16];
#pragma unroll
  for (int i = 0; i < 16; ++i) {
    const float ci = (float)((i & 7) + 16 * (i >> 3));
    sc[i] = fmaf(s[i], qs, fmaf(slope2, ci, -sb));
  }
  if (masked) {
#pragma unroll
    for (int i = 0; i < 16; ++i) {
      const int di = dt - ((i & 7) + 16 * (i >> 3));
      sc[i] = (di >= 0 && di < wlim) ? sc[i] : -3.0e38f;
    }
  }
  float tmax = sc[0];
#pragma unroll
  for (int i = 1; i < 16; ++i) tmax = fmaxf(tmax, sc[i]);
  tmax = fmaxf(tmax, xor32_f(tmax));
  if (__any(tmax > A.m)) {
    const float mnew = fmaxf(A.m, tmax);
    const float alpha = __builtin_amdgcn_exp2f(A.m - mnew);
    A.m = mnew;
    A.l *= alpha;
#pragma unroll
    for (int i = 0; i < 16; ++i) { A.o0[i] *= alpha; A.o1[i] *= alpha; }
  }
  float p[16]; float ps = 0.f;
#pragma unroll
  for (int i = 0; i < 16; ++i) { p[i] = __builtin_amdgcn_exp2f(sc[i] - A.m); ps += p[i]; }
  A.l += ps;
  pv_tile(A.o0, A.o1, vt, vstride, p);
}

DEV void att_tile64(AttAcc& A, const f32x16& s0, const f32x16& s1, float qs, float slope2, int dt, float lane_bias, bool masked, int wlim,
                    const bf16_t* vt, size_t vstride) {
  const float sb = slope2 * (float)dt + lane_bias;
  float sc[32];
#pragma unroll
  for (int i = 0; i < 16; ++i) {
    const int c = (i & 7) + 16 * (i >> 3);
    sc[i] = fmaf(s0[i], qs, fmaf(slope2, (float)c, -sb));
    sc[16 + i] = fmaf(s1[i], qs, fmaf(slope2, (float)(c + 32), -sb));
  }
  if (masked) {
#pragma unroll
    for (int i = 0; i < 32; ++i) {
      const int c = (i & 7) + 16 * ((i & 15) >> 3) + 32 * (i >> 4);
      const int di = dt - c;
      sc[i] = (di >= 0 && di < wlim) ? sc[i] : -3.0e38f;
    }
  }
  float tmax = sc[0];
#pragma unroll
  for (int i = 1; i < 32; ++i) tmax = fmaxf(tmax, sc[i]);
  tmax = fmaxf(tmax, xor32_f(tmax));
  if (__any(tmax > A.m)) {
    const float mnew = fmaxf(A.m, tmax);
    const float alpha = __builtin_amdgcn_exp2f(A.m - mnew);
    A.m = mnew;
    A.l *= alpha;
#pragma unroll
    for (int i = 0; i < 16; ++i) { A.o0[i] *= alpha; A.o1[i] *= alpha; }
  }
  float p[32]; float ps = 0.f;
#pragma unroll
  for (int i = 0; i < 32; ++i) { p[i] = __builtin_amdgcn_exp2f(sc[i] - A.m); ps += p[i]; }
  A.l += ps;
  pv_tile(A.o0, A.o1, vt, vstride, p);
  pv_tile(A.o0, A.o1, vt + 32, vstride, p + 16);
}

__device__ void nsa_item(const Params& P, int l, int item, char* smem) {
  const int b = item & 7, qt = item >> 3;
  const int t0 = qt * 32, cur = t0 >> 6;
  float* imp = (float*)smem;
  float* yacc = (float*)smem;
  float* ssq = (float*)(smem + 32768);
  unsigned char* selb = (unsigned char*)(smem + 33792);
  bf16_t* kvs = (bf16_t*)(smem + 34816);
  unsigned ykeep[16];
#pragma unroll
  for (int i = 0; i < 16; ++i) ykeep[i] = 0u;
  const bf16_t* Hb = P.H + (size_t)(b * SEQ) * HS;
#pragma unroll 1
  for (int g = 0; g < 2; ++g) {
    const int tid = opaque_tid(), lane = tid & 63, w = tid >> 6;
    const int q = lane & 31, hk = lane >> 5;
    const int t = t0 + q;
    const int km = kperm(q);
    float* yown = yacc + (w * 64 + 4 * hk) * 32 + q;
    const int head = g * 4 + w;
    const float slope = exp2f(-(float)(head + 1));
    bf16x8 qf[4];
    {
      const bf16_t* qrow = Hb + (size_t)t * HS + 1024 + head * 64 + hk * 8;
#pragma unroll
      for (int ks = 0; ks < 4; ++ks) qf[ks] = *(const bf16x8*)(qrow + ks * 16);
    }
    const bf16_t* grow = Hb + (size_t)t * HS + 2048 + head * 3;
    const float gc = sigmoid_f(bf2f(grow[0])), gs = sigmoid_f(bf2f(grow[1])), gwn = sigmoid_f(bf2f(grow[2]));
    const bf16_t* KCb = P.KC + (size_t)((b * 2 + g) * 256) * 64;
    const bf16_t* VCb = P.VCT + (size_t)((b * 2 + g) * 64) * 256;
    const int cmaxi = (2 * qt < 254) ? 2 * qt : 254;
    const int ntc = (cmaxi >> 5) + 1;
    float cm = -1e30f, cinv = 0.f;
    {
      float lsum = 0.f;
      bf16x8 kf[4], kn[4];
      load_kfrag(kf, KCb + (size_t)km * 64 + hk * 8);
#pragma unroll 1
      for (int kt = 0; kt < ntc; ++kt) {
        load_kfrag(kn, KCb + (size_t)(((kt + 1 < ntc) ? kt + 1 : kt) * 32 + km) * 64 + hk * 8);
        const f32x16 s = qk_regs(kf, qf);
#pragma unroll
        for (int ks = 0; ks < 4; ++ks) kf[ks] = kn[ks];
        float sv[16]; float tmax = -1e30f;
#pragma unroll
        for (int i = 0; i < 16; ++i) {
          const int c = kt * 32 + (i & 7) + 8 * hk + 16 * (i >> 3);
          const int dist = t - (16 * c + 31);
          sv[i] = (dist >= 0) ? (s[i] * 0.125f - slope * (float)dist) : -1e30f;
          tmax = fmaxf(tmax, sv[i]);
        }
        tmax = fmaxf(tmax, xor32_f(tmax));
        const float mnew = fmaxf(cm, tmax);
        float ps = 0.f;
#pragma unroll
        for (int i = 0; i < 16; ++i) ps += (sv[i] > -1e29f) ? __expf(sv[i] - mnew) : 0.f;
        lsum = lsum * __expf(cm - mnew) + ps;
        cm = mnew;
      }
      lsum += xor32_f(lsum);
      cinv = (lsum > 0.f) ? 1.f / lsum : 0.f;
    }
    f32x16 co0, co1;
#pragma unroll
    for (int i = 0; i < 16; ++i) { co0[i] = 0.f; co1[i] = 0.f; }
    {
      float carry15 = 0.f;
      bf16x8 kf[4], kn[4];
      load_kfrag(kf, KCb + (size_t)km * 64 + hk * 8);
#pragma unroll 1
      for (int kt = 0; kt < ntc; ++kt) {
        load_kfrag(kn, KCb + (size_t)(((kt + 1 < ntc) ? kt + 1 : kt) * 32 + km) * 64 + hk * 8);
        const f32x16 s = qk_regs(kf, qf);
#pragma unroll
        for (int ks = 0; ks < 4; ++ks) kf[ks] = kn[ks];
        float p[16];
#pragma unroll
        for (int i = 0; i < 16; ++i) {
          const int c = kt * 32 + (i & 7) + 8 * hk + 16 * (i >> 3);
          const int dist = t - (16 * c + 31);
          p[i] = (dist >= 0) ? __expf(s[i] * 0.125f - slope * (float)dist - cm) * cinv : 0.f;
        }
        const float x7 = xor32_f(p[7]), x15 = xor32_f(p[15]);
        const float prev0 = hk ? x7 : carry15;
        const float prev2 = hk ? x15 : x7;
        carry15 = x15;
        float* ib = imp + (w * 32 + q) * 64 + 8 * kt + 2 * hk;
        ib[0] = 2.f * (p[0] + p[1] + p[2]) + p[3] + prev0;
        ib[1] = 2.f * (p[4] + p[5] + p[6]) + p[7] + p[3];
        ib[4] = 2.f * (p[8] + p[9] + p[10]) + p[11] + prev2;
        ib[5] = 2.f * (p[12] + p[13] + p[14]) + p[15] + p[11];
        pv_tile(co0, co1, VCb + (size_t)q * 256 + kt * 32 + 8 * hk, 256, p);
      }
    }
    __syncthreads();
    {
      const int q2 = tid >> 3, js = tid & 7;
#pragma unroll
      for (int jj = 0; jj < 8; ++jj) {
        const int j = js * 8 + jj;
        float v = imp[(0 * 32 + q2) * 64 + j] + imp[(1 * 32 + q2) * 64 + j] + imp[(2 * 32 + q2) * 64 + j] + imp[(3 * 32 + q2) * 64 + j];
        if (j <= cur) { if (j == 0 || j == cur || j == cur - 1) v += 1e4f; }
        else v = -1e30f;
        imp[q2 * 64 + j] = v;
      }
      __syncthreads();
      float mine[8];
#pragma unroll
      for (int jj = 0; jj < 8; ++jj) mine[jj] = imp[q2 * 64 + js * 8 + jj];
      int cnt[8];
#pragma unroll
      for (int jj = 0; jj < 8; ++jj) cnt[jj] = 0;
#pragma unroll 4
      for (int j2 = 0; j2 < 64; ++j2) {
        const float v2 = imp[q2 * 64 + j2];
#pragma unroll
        for (int jj = 0; jj < 8; ++jj) {
          const int j = js * 8 + jj;
          cnt[jj] += ((v2 > mine[jj]) || (v2 == mine[jj] && j2 < j)) ? 1 : 0;
        }
      }
      unsigned bits = 0;
#pragma unroll
      for (int jj = 0; jj < 8; ++jj) bits |= (cnt[jj] < 16 ? 1u : 0u) << jj;
      selb[q2 * 8 + js] = (unsigned char)bits;
    }
    __syncthreads();
    const uint2 selw = *(const uint2*)(selb + q * 8);
    const unsigned long long selmask = (unsigned long long)selw.x | ((unsigned long long)selw.y << 32);

#pragma unroll
    for (int i = 0; i < 16; ++i) {
      yown[((i & 3) + 8 * (i >> 2)) * 32] = gc * co0[i];
      yown[(32 + (i & 3) + 8 * (i >> 2)) * 32] = gc * co1[i];
    }
    const float qs2 = 0.125f * 1.4426950408889634f, slope2 = slope * 1.4426950408889634f;
    float ss = 0.f;
#pragma unroll 1
    for (int br = 0; br < 2; ++br) {
      AttAcc A;
#pragma unroll
      for (int i = 0; i < 16; ++i) { A.o0[i] = 0.f; A.o1[i] = 0.f; }
      A.m = -1e30f; A.l = 0.f;
      const bf16_t* Kg = Hb + (br == 0 ? 1792 : 1920) + g * 64;
      const bf16_t* VTg = (br == 0 ? P.VsT : P.VwT) + (size_t)((b * 2 + g) * 64) * 4096;
      const int khi = t0 & ~63;
      const int klo = (br == 0) ? 0 : (((t0 - 512 > 0) ? (t0 - 512) : 0) & ~63);
      const int ntile = ((khi - klo) >> 6) + 1;
      const int wlim = (br == 0) ? (1 << 30) : 512;
      const int srow = tid >> 3, sc8 = (tid & 7) * 8;
      const int koff = kperm(srow) * 72 + sc8, voff = 4608 + srow * 72 + sc8;
      const bf16_t* kgp = Kg + (size_t)srow * HS + sc8;
      const bf16_t* vgp = VTg + (size_t)srow * 4096 + sc8;
      uint4 rk0, rk1, rv0, rv1;
      rk0 = *(const uint4*)(kgp + (size_t)khi * HS); rk1 = *(const uint4*)(kgp + (size_t)(khi + 32) * HS);
      rv0 = *(const uint4*)(vgp + khi); rv1 = *(const uint4*)(vgp + (size_t)32 * 4096 + khi);
      *(uint4*)(kvs + koff) = rk0; *(uint4*)(kvs + koff + 32 * 72) = rk1;
      *(uint4*)(kvs + voff) = rv0; *(uint4*)(kvs + voff + 32 * 72) = rv1;
      __syncthreads();
#pragma unroll 1
      for (int i = 0; i < ntile; ++i) {
        const int kb = khi - 64 * i;
        const bool more = (i + 1 < ntile);
        if (more) {
          rk0 = *(const uint4*)(kgp + (size_t)(kb - 64) * HS); rk1 = *(const uint4*)(kgp + (size_t)(kb - 32) * HS);
          rv0 = *(const uint4*)(vgp + kb - 64); rv1 = *(const uint4*)(vgp + (size_t)32 * 4096 + kb - 64);
        }
        const bf16_t* buf = kvs + (i & 1) * 9216;
        f32x16 s0, s1;
#pragma unroll
        for (int e = 0; e < 16; ++e) { s0[e] = 0.f; s1[e] = 0.f; }
        {
          const bf16_t* kl = buf + q * 72 + hk * 8;
#pragma unroll
          for (int ks = 0; ks < 4; ++ks) {
            s0 = mfma32(*(const bf16x8*)(kl + ks * 16), qf[ks], s0);
            s1 = mfma32(*(const bf16x8*)(kl + 32 * 72 + ks * 16), qf[ks], s1);
          }
        }
        float lane_bias = 0.f;
        if (br == 0) { const bool selj = (selmask >> (kb >> 6)) & 1ull; lane_bias = selj ? 0.f : 1e30f; }
        const bool masked = (kb + 63 > t0) || (br == 1 && kb <= t0 - 481);
        att_tile64(A, s0, s1, qs2, slope2, t - kb - 8 * hk, lane_bias, masked, wlim, buf + 4608 + q * 72 + 8 * hk, 72);
        if (more) {
          bf16_t* nb = kvs + ((i + 1) & 1) * 9216;
          *(uint4*)(nb + koff) = rk0; *(uint4*)(nb + koff + 32 * 72) = rk1;
          *(uint4*)(nb + voff) = rv0; *(uint4*)(nb + voff + 32 * 72) = rv1;
        }
        __syncthreads();
      }
      const float lt = A.l + xor32_f(A.l);
      const float sc = (lt > 0.f) ? (br == 0 ? gs : gwn) / lt : 0.f;
      if (br == 0) {
#pragma unroll
        for (int i = 0; i < 16; ++i) {
          yown[((i & 3) + 8 * (i >> 2)) * 32] += sc * A.o0[i];
          yown[(32 + (i & 3) + 8 * (i >> 2)) * 32] += sc * A.o1[i];
        }
      } else {
        float y0[16], y1[16];
#pragma unroll
        for (int i = 0; i < 16; ++i) {
          const int d0 = (i & 3) + 8 * (i >> 2);
          y0[i] = yown[d0 * 32] + sc * A.o0[i];
          y1[i] = yown[(32 + d0) * 32] + sc * A.o1[i];
          ss += y0[i] * y0[i] + y1[i] * y1[i];
        }
        if (g == 0) {
#pragma unroll
          for (int i2 = 0; i2 < 8; ++i2) { ykeep[i2] = pack2(y0[2 * i2], y0[2 * i2 + 1]); ykeep[8 + i2] = pack2(y1[2 * i2], y1[2 * i2 + 1]); }
        } else {
#pragma unroll
          for (int i = 0; i < 16; ++i) {
            const int d0 = (i & 3) + 8 * (i >> 2);
            yown[d0 * 32] = y0[i];
            yown[(32 + d0) * 32] = y1[i];
          }
        }
      }
    }
    ss += xor32_f(ss);
    if (hk == 0) ssq[q * 8 + head] = ss;
    __syncthreads();
  }
  {
    const float* gn = P.gn_nsa_g + l * 512;
    const int tid = opaque_tid(), lane = tid & 63, w = tid >> 6;
    {
      const int q = lane & 31, hk = lane >> 5;
      float tot = 0.f;
#pragma unroll
      for (int hh = 0; hh < 8; ++hh) tot += ssq[q * 8 + hh];
      const float rs = rsqrtf(tot * (1.f / 512.f) + EPS_C);
      bf16_t* dst = P.CAT + (size_t)(b * SEQ + t0 + q) * 1024 + 512 + w * 64;
      const float* gh = gn + w * 64;
#pragma unroll
      for (int i4 = 0; i4 < 4; ++i4) {
        const int d = 8 * i4 + 4 * hk;
        const float4 ga = *(const float4*)(gh + d), gb = *(const float4*)(gh + 32 + d);
        uint2 o;
        o.x = pack2(lo_f(ykeep[2 * i4]) * rs * ga.x, hi_f(ykeep[2 * i4]) * rs * ga.y);
        o.y = pack2(lo_f(ykeep[2 * i4 + 1]) * rs * ga.z, hi_f(ykeep[2 * i4 + 1]) * rs * ga.w);
        *(uint2*)(dst + d) = o;
        o.x = pack2(lo_f(ykeep[8 + 2 * i4]) * rs * gb.x, hi_f(ykeep[8 + 2 * i4]) * rs * gb.y);
        o.y = pack2(lo_f(ykeep[8 + 2 * i4 + 1]) * rs * gb.z, hi_f(ykeep[8 + 2 * i4 + 1]) * rs * gb.w);
        *(uint2*)(dst + 32 + d) = o;
      }
    }
    {
      const int q2 = tid & 31, cg8 = tid >> 5;
      float tot = 0.f;
#pragma unroll
      for (int hh = 0; hh < 8; ++hh) tot += ssq[q2 * 8 + hh];
      const float rs = rsqrtf(tot * (1.f / 512.f) + EPS_C);
      bf16_t* dst = P.CAT + (size_t)(b * SEQ + t0 + q2) * 1024 + 512 + 256;
#pragma unroll
      for (int c8 = 0; c8 < 4; ++c8) {
        const int cl = cg8 * 32 + c8 * 8;
        float o1[8];
#pragma unroll
        for (int k = 0; k < 8; ++k) o1[k] = yacc[(cl + k) * 32 + q2] * rs * gn[256 + cl + k];
        *(bf16x8*)(dst + cl) = pack8(o1);
      }
    }
  }
  __syncthreads();
}

DEV void ln_row(const float* g, const float* bta, bf16_t* xb, int lane, const float (&pre)[16]) {
  float s = 0.f;
#pragma unroll
  for (int k = 0; k < 16; ++k) s += pre[k];
  const float mean = wave_sum(s) * (1.f / 1024.f);
  float v = 0.f;
#pragma unroll
  for (int k = 0; k < 16; ++k) { const float d = pre[k] - mean; v += d * d; }
  const float rstd = rsqrtf(wave_sum(v) * (1.f / 1024.f) + EPS_C);
#pragma unroll
  for (int hsel = 0; hsel < 2; ++hsel) {
    const int c0 = hsel * 512 + lane * 8;
    const float4 ga = *(const float4*)(g + c0), gb = *(const float4*)(g + c0 + 4);
    const float4 ba = *(const float4*)(bta + c0), bb = *(const float4*)(bta + c0 + 4);
    float o[8];
    o[0] = (pre[hsel * 8 + 0] - mean) * rstd * ga.x + ba.x; o[1] = (pre[hsel * 8 + 1] - mean) * rstd * ga.y + ba.y;
    o[2] = (pre[hsel * 8 + 2] - mean) * rstd * ga.z + ba.z; o[3] = (pre[hsel * 8 + 3] - mean) * rstd * ga.w + ba.w;
    o[4] = (pre[hsel * 8 + 4] - mean) * rstd * gb.x + bb.x; o[5] = (pre[hsel * 8 + 5] - mean) * rstd * gb.y + bb.y;
    o[6] = (pre[hsel * 8 + 6] - mean) * rstd * gb.z + bb.z; o[7] = (pre[hsel * 8 + 7] - mean) * rstd * gb.w + bb.w;
    *(bf16x8*)(xb + c0) = pack8(o);
  }
}
__device__ void ln1_phase(const Params& P, int l) {
  const int lane = opaque_tid() & 63, w = opaque_tid() >> 6;
  for (int r4 = blockIdx.x; r4 < T_TOK / 4; r4 += gridDim.x) {
    const int t = r4 * 4 + w;
    const bf16_t* mx = P.MIX + (size_t)t * 1024;
    bf16_t* xb = P.XB + (size_t)t * 1024;
    float pre[16];
#pragma unroll
    for (int hsel = 0; hsel < 2; ++hsel) {
      float r[8];
      if (l == 0) {
        const float* xr = P.x + (size_t)t * 1024 + hsel * 512 + lane * 8;
        const float4 a = *(const float4*)xr, b = *(const float4*)(xr + 4);
        r[0] = a.x; r[1] = a.y; r[2] = a.z; r[3] = a.w; r[4] = b.x; r[5] = b.y; r[6] = b.z; r[7] = b.w;
      } else {
        const uint4 xx = *(const uint4*)(xb + hsel * 512 + lane * 8);
        r[0] = lo_f(xx.x); r[1] = hi_f(xx.x); r[2] = lo_f(xx.y); r[3] = hi_f(xx.y); r[4] = lo_f(xx.z); r[5] = hi_f(xx.z); r[6] = lo_f(xx.w); r[7] = hi_f(xx.w);
      }
      const uint4 mm = *(const uint4*)(mx + hsel * 512 + lane * 8);
      pre[hsel * 8 + 0] = ALPHA_C * r[0] + lo_f(mm.x); pre[hsel * 8 + 1] = ALPHA_C * r[1] + hi_f(mm.x);
      pre[hsel * 8 + 2] = ALPHA_C * r[2] + lo_f(mm.y); pre[hsel * 8 + 3] = ALPHA_C * r[3] + hi_f(mm.y);
      pre[hsel * 8 + 4] = ALPHA_C * r[4] + lo_f(mm.z); pre[hsel * 8 + 5] = ALPHA_C * r[5] + hi_f(mm.z);
      pre[hsel * 8 + 6] = ALPHA_C * r[6] + lo_f(mm.w); pre[hsel * 8 + 7] = ALPHA_C * r[7] + hi_f(mm.w);
    }
    ln_row(P.ln1_g + l * 1024, P.ln1_b + l * 1024, xb, lane, pre);
  }
}

DEV unsigned fkey(float v) { const unsigned u = __float_as_uint(v); return (u & 0x80000000u) ? ~u : (u | 0x80000000u); }
DEV float keyf(unsigned k) { const unsigned u = (k & 0x80000000u) ? (k ^ 0x80000000u) : ~k; return __uint_as_float(u); }
#define TK_INS(L, val) { unsigned _v = (val); _Pragma("unroll") for (int _i = 0; _i < 16; ++_i) { const unsigned _hi = max(L[_i], _v); _v = min(L[_i], _v); L[_i] = _hi; } }

#define TK_CE(a, b) { const unsigned _h = max(a, b), _l = min(a, b); a = _h; b = _l; }
DEV void sort16_desc(unsigned (&x)[16]) {
#pragma unroll
  for (int k = 2; k <= 16; k <<= 1)
#pragma unroll
    for (int j = k >> 1; j > 0; j >>= 1)
#pragma unroll
      for (int i = 0; i < 16; ++i) {
        const int p = i ^ j;
        if (p > i) {
          if ((i & k) == 0) { TK_CE(x[i], x[p]); } else { TK_CE(x[p], x[i]); }
        }
      }
}
DEV void merge_top16(unsigned (&x)[16], const unsigned (&y)[16]) {
#pragma unroll
  for (int i = 0; i < 16; ++i) x[i] = max(x[i], y[15 - i]);
#pragma unroll
  for (int j = 8; j > 0; j >>= 1)
#pragma unroll
    for (int i = 0; i < 16; ++i) {
      const int p = i ^ j;
      if (p > i) { TK_CE(x[i], x[p]); }
    }
}
__device__ void peer_topk_item(const Params& P, int l, int bitem, char* smem) {
  const int tid = opaque_tid(), lane = tid & 63, w = tid >> 6;
  const int q = lane & 31, hk = lane >> 5;
  unsigned char* idxs = (unsigned char*)smem + w * 1024;
  const int wi = bitem * 4 + w;
  const int tile = wi >> 3, h = wi & 7;
  const int t = tile * 32 + q;
  unsigned L0[16], L1[16];
#pragma unroll
  for (int i = 0; i < 16; ++i) { L0[i] = 0u; L1[i] = 0u; }
#pragma unroll 1
  for (int c = 0; c < 2; ++c) {
    unsigned Lc[16];
#pragma unroll
    for (int i = 0; i < 16; ++i) Lc[i] = 0u;
    f32x16 acc[4];
#pragma unroll
    for (int mt = 0; mt < 4; ++mt)
#pragma unroll
      for (int i = 0; i < 16; ++i) acc[mt][i] = 0.f;
    const bf16_t* qrow = P.QP + (size_t)t * 2048 + h * 256 + c * 128 + hk * 8;
    const bf16_t* sk = P.SK + (size_t)((l * 2 + c) * 128) * 128 + (size_t)q * 128 + hk * 8;
#pragma unroll
    for (int ks = 0; ks < 8; ++ks) {
      const bf16x8 bq = *(const bf16x8*)(qrow + ks * 16);
#pragma unroll
      for (int mt = 0; mt < 4; ++mt) {
        const bf16x8 a = *(const bf16x8*)(sk + (size_t)(mt * 32) * 128 + ks * 16);
        acc[mt] = mfma32(a, bq, acc[mt]);
      }
    }
    {
      unsigned G1[16], G2[16], G3[16];
#pragma unroll
      for (int i = 0; i < 16; ++i) {
        const int kb0 = (i & 3) + 8 * (i >> 2) + 4 * hk;
        Lc[i] = (fkey(acc[0][i]) & ~0x7Fu) | (unsigned)(127 - kb0);
        G1[i] = (fkey(acc[1][i]) & ~0x7Fu) | (unsigned)(127 - (32 + kb0));
        G2[i] = (fkey(acc[2][i]) & ~0x7Fu) | (unsigned)(127 - (64 + kb0));
        G3[i] = (fkey(acc[3][i]) & ~0x7Fu) | (unsigned)(127 - (96 + kb0));
      }
      sort16_desc(Lc); sort16_desc(G1); sort16_desc(G2); sort16_desc(G3);
      merge_top16(Lc, G1); merge_top16(G2, G3); merge_top16(Lc, G2);
    }
    {
      unsigned oth[16];
#pragma unroll
      for (int i = 0; i < 16; ++i) oth[i] = xor32_u(Lc[i]);
      merge_top16(Lc, oth);
    }
    if (hk == 0) {
#pragma unroll
      for (int i = 0; i < 16; ++i) idxs[q * 32 + c * 16 + i] = (unsigned char)(127u - (Lc[i] & 0x7Fu));
    }
#pragma unroll
    for (int i = 0; i < 16; ++i) { L0[i] = L1[i]; L1[i] = Lc[i]; }
  }
  unsigned C[16];
#pragma unroll
  for (int i = 0; i < 16; ++i) C[i] = 0u;
#pragma unroll
  for (int i = 0; i < 16; ++i) {
    const float v0 = keyf(L0[i] & ~0x7Fu);
#pragma unroll
    for (int j = 0; j < 16; ++j) {
      if ((i + 1) * (j + 1) <= 16) {
        const float v = v0 + keyf(L1[j] & ~0x7Fu);
        const unsigned key = (fkey(v) & ~0xFFu) | (unsigned)(255 - (i * 16 + j));
        TK_INS(C, key);
      }
    }
  }
  float cv[16]; float den = 0.f;
  const float cmax = keyf(C[0] & ~0xFFu);
#pragma unroll
  for (int k = 0; k < 16; ++k) { cv[k] = __expf(keyf(C[k] & ~0xFFu) - cmax); den += cv[k]; }
  const float rden = 1.f / den;
  __syncthreads();
#pragma unroll
  for (int k = 0; k < 8; ++k) {
    const unsigned hmsk = (unsigned)(-hk);
    const unsigned ck = (C[k] & ~hmsk) | (C[k + 8] & hmsk);
    const float gk = __uint_as_float((__float_as_uint(cv[k]) & ~hmsk) | (__float_as_uint(cv[k + 8]) & hmsk)) * rden;
    const int flat = 255 - (int)(ck & 0xFFu);
    const int ea = idxs[q * 32 + (flat >> 4)], eb = idxs[q * 32 + 16 + (flat & 15)];
    const size_t o = (size_t)t * 128 + h * 16 + hk * 8 + k;
    P.EXP[o] = ea * 128 + eb;
    P.GATE[o] = gk;
  }
  __syncthreads();
}


__device__ void peer_q_topk_item(const Params& P, int l, int item, char* smem) {
  bf16_t* As = (bf16_t*)smem;
  bf16_t* Bs = As + 128 * 72;
  bf16_t* Qs = (bf16_t*)(smem + 36864);
  unsigned char* idxs = (unsigned char*)smem;
  const int tid = opaque_tid(), lane = tid & 63, w = tid >> 6;
  const int wm = w >> 1, wn = w & 1, lr = lane & 31, hk = lane >> 5;
  const int q = lr;
  const int mt = item >> 3, h = item & 7;
  const int m0 = mt * 128;
  const int t = m0 + w * 32 + q;
  unsigned L0[16], L1[16];
#pragma unroll
  for (int i = 0; i < 16; ++i) { L0[i] = 0u; L1[i] = 0u; }
#pragma unroll 1
  for (int c = 0; c < 2; ++c) {
    {
      f32x16 acc[2][2];
      gemm_core(P.XB, P.WqT + (size_t)l * 2048 * 1024, m0, (h * 2 + c) * 128, As, Bs, tid, acc);
#pragma unroll
      for (int mi = 0; mi < 2; ++mi)
#pragma unroll
        for (int ni = 0; ni < 2; ++ni) {
          const int col = wn * 64 + ni * 32 + lr;
          const int rbase = wm * 64 + mi * 32 + 4 * hk;
#pragma unroll
          for (int i = 0; i < 16; ++i) Qs[(rbase + (i & 3) + 8 * (i >> 2)) * 136 + col] = f2bf(acc[mi][ni][i]);
        }
    }
    __syncthreads();
    {
      const bf16_t* skg = P.SK + (size_t)((l * 2 + c) * 128) * 128;
#pragma unroll
      for (int k = 0; k < 8; ++k) {
        const int ch = tid + 256 * k;
        const int row = ch >> 4, c8 = (ch & 15) * 8;
        *(uint4*)(As + row * 136 + c8) = *(const uint4*)(skg + row * 128 + c8);
      }
    }
    __syncthreads();
    unsigned Lc[16];
    {
      f32x16 sa[4];
#pragma unroll
      for (int m4 = 0; m4 < 4; ++m4)
#pragma unroll
        for (int i = 0; i < 16; ++i) sa[m4][i] = 0.f;
      const bf16_t* qrow = Qs + (w * 32 + q) * 136 + hk * 8;
      const bf16_t* sk = As + q * 136 + hk * 8;
#pragma unroll
      for (int ks = 0; ks < 8; ++ks) {
        const bf16x8 bq = *(const bf16x8*)(qrow + ks * 16);
#pragma unroll
        for (int m4 = 0; m4 < 4; ++m4) {
          const bf16x8 a = *(const bf16x8*)(sk + (m4 * 32) * 136 + ks * 16);
          sa[m4] = mfma32(a, bq, sa[m4]);
        }
      }
      unsigned G1[16], G2[16], G3[16];
#pragma unroll
      for (int i = 0; i < 16; ++i) {
        const int kb0 = (i & 3) + 8 * (i >> 2) + 4 * hk;
        Lc[i] = (fkey(sa[0][i]) & ~0x7Fu) | (unsigned)(127 - kb0);
        G1[i] = (fkey(sa[1][i]) & ~0x7Fu) | (unsigned)(127 - (32 + kb0));
        G2[i] = (fkey(sa[2][i]) & ~0x7Fu) | (unsigned)(127 - (64 + kb0));
        G3[i] = (fkey(sa[3][i]) & ~0x7Fu) | (unsigned)(127 - (96 + kb0));
      }
      sort16_desc(Lc); sort16_desc(G1); sort16_desc(G2); sort16_desc(G3);
      merge_top16(Lc, G1); merge_top16(G2, G3); merge_top16(Lc, G2);
    }
    {
      unsigned oth[16];
#pragma unroll
      for (int i = 0; i < 16; ++i) oth[i] = xor32_u(Lc[i]);
      merge_top16(Lc, oth);
    }
#pragma unroll
    for (int i = 0; i < 16; ++i) { L0[i] = L1[i]; L1[i] = Lc[i]; }
  }
  unsigned C[16], GB[16], GC[16];
  float v0s[16], v1s[16];
#pragma unroll
  for (int i = 0; i < 16; ++i) { v0s[i] = keyf(L0[i] & ~0x7Fu); v1s[i] = keyf(L1[i] & ~0x7Fu); }
#define CKEY(i, j) ((fkey(v0s[i] + v1s[j]) & ~0xFFu) | (unsigned)(255 - ((i) * 16 + (j))))
#pragma unroll
  for (int j = 0; j < 16; ++j) C[j] = CKEY(0, j);
#pragma unroll
  for (int j = 0; j < 8; ++j) GB[j] = CKEY(1, j);
#pragma unroll
  for (int j = 0; j < 5; ++j) GB[8 + j] = CKEY(2, j);
#pragma unroll
  for (int j = 0; j < 3; ++j) GB[13 + j] = CKEY(4, j);
#pragma unroll
  for (int j = 0; j < 4; ++j) GC[j] = CKEY(3, j);
  GC[4] = CKEY(5, 0); GC[5] = CKEY(5, 1); GC[6] = CKEY(6, 0); GC[7] = CKEY(6, 1); GC[8] = CKEY(7, 0); GC[9] = CKEY(7, 1);
  GC[10] = CKEY(8, 0); GC[11] = CKEY(9, 0); GC[12] = CKEY(10, 0); GC[13] = CKEY(11, 0); GC[14] = CKEY(12, 0); GC[15] = CKEY(13, 0);
  sort16_desc(GB); sort16_desc(GC);
  merge_top16(C, GB); merge_top16(C, GC);
  { const unsigned k14 = CKEY(14, 0), k15 = CKEY(15, 0); TK_INS(C, k14); TK_INS(C, k15); }
#undef CKEY
  float cv[16]; float den = 0.f;
  const float cmax = keyf(C[0] & ~0xFFu);
#pragma unroll
  for (int k = 0; k < 16; ++k) { cv[k] = __expf(keyf(C[k] & ~0xFFu) - cmax); den += cv[k]; }
  const float rden = 1.f / den;
  __syncthreads();
  if (hk == 0) {
#pragma unroll
    for (int i = 0; i < 16; ++i) {
      idxs[w * 1024 + q * 32 + i] = (unsigned char)(127u - (L0[i] & 0x7Fu));
      idxs[w * 1024 + q * 32 + 16 + i] = (unsigned char)(127u - (L1[i] & 0x7Fu));
    }
  }
  __syncthreads();
  {
    int eo[8]; float go[8];
    const unsigned hmsk = (unsigned)(-hk);
#pragma unroll
    for (int k = 0; k < 8; ++k) {
      const unsigned ck = (C[k] & ~hmsk) | (C[k + 8] & hmsk);
      go[k] = __uint_as_float((__float_as_uint(cv[k]) & ~hmsk) | (__float_as_uint(cv[k + 8]) & hmsk)) * rden;
      const int flat = 255 - (int)(ck & 0xFFu);
      const int ea = idxs[w * 1024 + q * 32 + (flat >> 4)], eb = idxs[w * 1024 + q * 32 + 16 + (flat & 15)];
      eo[k] = ea * 128 + eb;
    }
    const size_t o = (size_t)t * 128 + h * 16 + hk * 8;
    int4 e0, e1; e0.x = eo[0]; e0.y = eo[1]; e0.z = eo[2]; e0.w = eo[3]; e1.x = eo[4]; e1.y = eo[5]; e1.z = eo[6]; e1.w = eo[7];
    float4 g0, g1; g0.x = go[0]; g0.y = go[1]; g0.z = go[2]; g0.w = go[3]; g1.x = go[4]; g1.y = go[5]; g1.z = go[6]; g1.w = go[7];
    *(int4*)(P.EXP + o) = e0; *(int4*)(P.EXP + o + 4) = e1;
    *(float4*)(P.GATE + o) = g0; *(float4*)(P.GATE + o + 4) = g1;
  }
  __syncthreads();
}

DEV f32x2 cvt8(unsigned w, bool hi) { return hi ? __builtin_amdgcn_cvt_pk_f32_fp8((int)w, true) : __builtin_amdgcn_cvt_pk_f32_fp8((int)w, false); }
__device__ void peer_gather_phase(const Params& P, int l, bool do_store) {
  const int lane = opaque_tid() & 63, w = opaque_tid() >> 6;
  const unsigned char* U = P.U8 + (size_t)l * 16384 * 768 + (lane & 31) * 24;
  const unsigned char* V = P.V8 + (size_t)l * 16384 * 512 + lane * 8;
  const float* SU = P.SU + l * 16384;
  const float* SV = P.SV + l * 16384;
  int nev0, nev1; float ngv0, ngv1; uint4 nxa, nxc;
  {
    const int t = blockIdx.x * 4 + w;
    nev0 = P.EXP[(size_t)t * 128 + lane]; nev1 = P.EXP[(size_t)t * 128 + 64 + lane];
    ngv0 = P.GATE[(size_t)t * 128 + lane]; ngv1 = P.GATE[(size_t)t * 128 + 64 + lane];
    const bf16_t* xb = P.XB + (size_t)t * 1024 + lane * 16;
    nxa = *(const uint4*)xb; nxc = *(const uint4*)(xb + 8);
  }
  for (int r4 = blockIdx.x; r4 < T_TOK / 4; r4 += gridDim.x) {
    const int t = r4 * 4 + w;
    f32x2 xf[8];
    const int ev0 = nev0, ev1 = nev1; const float gv0 = ngv0, gv1 = ngv1;
    {
      const uint4 xa = nxa, xc = nxc;
      xf[0] = f32x2{lo_f(xa.x), hi_f(xa.x)}; xf[1] = f32x2{lo_f(xa.y), hi_f(xa.y)}; xf[2] = f32x2{lo_f(xa.z), hi_f(xa.z)}; xf[3] = f32x2{lo_f(xa.w), hi_f(xa.w)};
      xf[4] = f32x2{lo_f(xc.x), hi_f(xc.x)}; xf[5] = f32x2{lo_f(xc.y), hi_f(xc.y)}; xf[6] = f32x2{lo_f(xc.z), hi_f(xc.z)}; xf[7] = f32x2{lo_f(xc.w), hi_f(xc.w)};
    }
    f32x2 xu[16];
    {
      const bf16_t* xq = P.XB + (size_t)t * 1024 + (lane & 31) * 32;
      const uint4 q0 = *(const uint4*)xq, q1 = *(const uint4*)(xq + 8), q2 = *(const uint4*)(xq + 16), q3 = *(const uint4*)(xq + 24);
      xu[0] = f32x2{lo_f(q0.x), hi_f(q0.x)}; xu[1] = f32x2{lo_f(q0.y), hi_f(q0.y)}; xu[2] = f32x2{lo_f(q0.z), hi_f(q0.z)}; xu[3] = f32x2{lo_f(q0.w), hi_f(q0.w)};
      xu[4] = f32x2{lo_f(q1.x), hi_f(q1.x)}; xu[5] = f32x2{lo_f(q1.y), hi_f(q1.y)}; xu[6] = f32x2{lo_f(q1.z), hi_f(q1.z)}; xu[7] = f32x2{lo_f(q1.w), hi_f(q1.w)};
      xu[8] = f32x2{lo_f(q2.x), hi_f(q2.x)}; xu[9] = f32x2{lo_f(q2.y), hi_f(q2.y)}; xu[10] = f32x2{lo_f(q2.z), hi_f(q2.z)}; xu[11] = f32x2{lo_f(q2.w), hi_f(q2.w)};
      xu[12] = f32x2{lo_f(q3.x), hi_f(q3.x)}; xu[13] = f32x2{lo_f(q3.y), hi_f(q3.y)}; xu[14] = f32x2{lo_f(q3.z), hi_f(q3.z)}; xu[15] = f32x2{lo_f(q3.w), hi_f(q3.w)};
    }
    f32x2 y[8];
#pragma unroll
    for (int k = 0; k < 8; ++k) y[k] = f32x2{0.f, 0.f};
    {
      const int r4n = (r4 + (int)gridDim.x < T_TOK / 4) ? r4 + (int)gridDim.x : r4;
      const int tn = r4n * 4 + w;
      nev0 = P.EXP[(size_t)tn * 128 + lane]; nev1 = P.EXP[(size_t)tn * 128 + 64 + lane];
      ngv0 = P.GATE[(size_t)tn * 128 + lane]; ngv1 = P.GATE[(size_t)tn * 128 + 64 + lane];
      const bf16_t* xbn = P.XB + (size_t)tn * 1024 + lane * 16;
      nxa = *(const uint4*)xbn; nxc = *(const uint4*)(xbn + 8);
    }
    const float sux0 = SU[ev0], sux1 = SU[ev1];
    const float gsx0 = gv0 * SV[ev0], gsx1 = gv1 * SV[ev1];
    const bool uphi = (lane >= 32);
    uint2 uA[12], uB[12]; uint2 vA[8], vB[8];
    auto load_batch = [&](uint2 (&u6)[12], uint2 (&v8)[8], int bt) {
      const int evs = (bt < 8) ? ev0 : ev1;
      const int kb = (bt & 7) * 8;
#pragma unroll
      for (int pr = 0; pr < 4; ++pr) {
        const int ea = __builtin_amdgcn_readlane(evs, kb + 2 * pr), eb = __builtin_amdgcn_readlane(evs, kb + 2 * pr + 1);
        const uint2* up = (const uint2*)(U + (size_t)(uphi ? eb : ea) * 768);
        u6[3 * pr] = up[0]; u6[3 * pr + 1] = up[1]; u6[3 * pr + 2] = up[2];
        v8[2 * pr] = *(const uint2*)(V + (size_t)ea * 512);
        v8[2 * pr + 1] = *(const uint2*)(V + (size_t)eb * 512);
      }
    };
    auto compute_batch = [&](const uint2 (&u6)[12], const uint2 (&v8)[8], int bt) {
      const int kb = (bt & 7) * 8;
      float dvec = 0.f;
#pragma unroll
      for (int pr = 0; pr < 4; ++pr) {
        v6u_t qv; qv[0] = u6[3 * pr].x; qv[1] = u6[3 * pr].y; qv[2] = u6[3 * pr + 1].x; qv[3] = u6[3 * pr + 1].y; qv[4] = u6[3 * pr + 2].x; qv[5] = u6[3 * pr + 2].y;
        const v32f_t wv = __builtin_amdgcn_cvt_scalef32_pk32_f32_fp6(qv, 1.0f);
        f32x2 a2 = f32x2{0.f, 0.f};
#pragma unroll
        for (int i = 0; i < 16; ++i) a2 += f32x2{wv[2 * i], wv[2 * i + 1]} * xu[i];
        float hs = a2.x + a2.y;
        hs += dpp_row_shr(hs, 1); hs += dpp_row_shr(hs, 2); hs += dpp_row_shr(hs, 4); hs += dpp_row_shr(hs, 8);
        hs += __builtin_bit_cast(float, __builtin_amdgcn_update_dpp(0, __builtin_bit_cast(int, hs), 0x142, 0xa, 0xf, false));
        const float da = __builtin_bit_cast(float, __builtin_amdgcn_readlane(__builtin_bit_cast(int, hs), 31));
        const float db = __builtin_bit_cast(float, __builtin_amdgcn_readlane(__builtin_bit_cast(int, hs), 63));
        dvec = (lane == kb + 2 * pr) ? da : dvec;
        dvec = (lane == kb + 2 * pr + 1) ? db : dvec;
      }
      const float sux = (bt < 8) ? sux0 : sux1;
      const float gsx = (bt < 8) ? gsx0 : gsx1;
      const float avec = gelu_t(dvec * sux) * gsx;
#pragma unroll
      for (int j = 0; j < 8; ++j) {
        const float a = __builtin_bit_cast(float, __builtin_amdgcn_readlane(__builtin_bit_cast(int, avec), kb + j));
        const f32x2 aa = f32x2{a, a};
        y[0] += aa * __builtin_amdgcn_cvt_scalef32_pk_f32_fp4(v8[j].x, 1.0f, 0); y[1] += aa * __builtin_amdgcn_cvt_scalef32_pk_f32_fp4(v8[j].x, 1.0f, 1);
        y[2] += aa * __builtin_amdgcn_cvt_scalef32_pk_f32_fp4(v8[j].x, 1.0f, 2); y[3] += aa * __builtin_amdgcn_cvt_scalef32_pk_f32_fp4(v8[j].x, 1.0f, 3);
        y[4] += aa * __builtin_amdgcn_cvt_scalef32_pk_f32_fp4(v8[j].y, 1.0f, 0); y[5] += aa * __builtin_amdgcn_cvt_scalef32_pk_f32_fp4(v8[j].y, 1.0f, 1);
        y[6] += aa * __builtin_amdgcn_cvt_scalef32_pk_f32_fp4(v8[j].y, 1.0f, 2); y[7] += aa * __builtin_amdgcn_cvt_scalef32_pk_f32_fp4(v8[j].y, 1.0f, 3);
      }
    };
    load_batch(uA, vA, 0);
#pragma unroll 1
    for (int bt = 0; bt < 16; bt += 2) {
      load_batch(uB, vB, bt + 1);
      compute_batch(uA, vA, bt);
      load_batch(uA, vA, (bt + 2 < 16) ? bt + 2 : 15);
      compute_batch(uB, vB, bt + 1);
    }
    float* xfp = P.out + (size_t)t * 1024 + lane * 16;
    float pre[16];
#pragma unroll
    for (int k2 = 0; k2 < 8; ++k2) {
      pre[2 * k2 + 0] = ALPHA_C * xf[k2].x + y[k2].x;
      pre[2 * k2 + 1] = ALPHA_C * xf[k2].y + y[k2].y;
    }
    float sm = 0.f;
#pragma unroll
    for (int k = 0; k < 16; ++k) sm += pre[k];
    const float mean = wave_sum(sm) * (1.f / 1024.f);
    float vs = 0.f;
#pragma unroll
    for (int k = 0; k < 16; ++k) { const float dd = pre[k] - mean; vs += dd * dd; }
    const float rstd = rsqrtf(wave_sum(vs) * (1.f / 1024.f) + EPS_C);
    const float* g2 = P.ln2_g + l * 1024 + lane * 16;
    const float* b2 = P.ln2_b + l * 1024 + lane * 16;
    float o[16];
#pragma unroll
    for (int k4 = 0; k4 < 4; ++k4) {
      const float4 gg = *(const float4*)(g2 + 4 * k4), bb = *(const float4*)(b2 + 4 * k4);
      o[4 * k4 + 0] = (pre[4 * k4 + 0] - mean) * rstd * gg.x + bb.x; o[4 * k4 + 1] = (pre[4 * k4 + 1] - mean) * rstd * gg.y + bb.y;
      o[4 * k4 + 2] = (pre[4 * k4 + 2] - mean) * rstd * gg.z + bb.z; o[4 * k4 + 3] = (pre[4 * k4 + 3] - mean) * rstd * gg.w + bb.w;
      float4 ov; ov.x = o[4 * k4]; ov.y = o[4 * k4 + 1]; ov.z = o[4 * k4 + 2]; ov.w = o[4 * k4 + 3];
      if (do_store && l == 1) *(float4*)(xfp + 4 * k4) = ov;
    }
    bf16_t* xbo = P.XB + (size_t)t * 1024 + lane * 16;
    if (do_store && l == 0) {
      *(bf16x8*)(xbo) = pack8(o);
      *(bf16x8*)(xbo + 8) = pack8(o + 8);
    } else if (o[0] == 123456.789f) {
      *(bf16x8*)(xbo) = pack8(o);
    }
  }
}

#define XB_TMO      128
#define XB_XCNT(j)  (256  + 64 * (j))
#define XB_XSUB(j)  (1280 + 64 * (j))
#define XB_XGEN(j)  (2304 + 64 * (j))
#define XB_TOP      3328
#define XB_TOPGEN   3392
#define XCD_BAR_WORDS 3456
#define XB_SPIN_CAP (1u << 22)
#define LAS __attribute__((address_space(3)))
DEV unsigned xb_ld(unsigned* p)              { return __hip_atomic_load(p, __ATOMIC_RELAXED, __HIP_MEMORY_SCOPE_AGENT); }
DEV unsigned xb_add(unsigned* p, unsigned v) { return __hip_atomic_fetch_add(p, v, __ATOMIC_RELAXED, __HIP_MEMORY_SCOPE_AGENT); }
DEV unsigned xb_xcc_id() { return (unsigned)__builtin_amdgcn_s_getreg((3 << 11) | 20) & 0xFu; }
#define XB_SPIN(cond, bar) do { unsigned _sp = 0; while (cond) { __builtin_amdgcn_s_sleep(1); \
    if ((++_sp & 255u) == 0u) { if (xb_ld(&(bar)[XB_TMO])) break; if (_sp > XB_SPIN_CAP) { atomicAdd(&(bar)[XB_TMO], 1u); break; } } } } while (0)
struct XcdBarrier { unsigned* bar; unsigned x; volatile LAS unsigned* st; };
DEV XcdBarrier xcd_barrier_post(unsigned* bar, volatile LAS unsigned* st) {
  XcdBarrier b; b.bar = bar; b.x = xb_xcc_id(); b.st = st;
  if (threadIdx.x == 0) (void)xb_add(&bar[XB_XCNT(b.x)], 1u);
  return b;
}
DEV void xcd_barrier_complete(unsigned* bar, unsigned x, unsigned& nloc, unsigned& nx) {
  const unsigned G = gridDim.x * gridDim.y * gridDim.z;
  unsigned sum, cnt, mine, sp = 0u;
  for (;;) {
    sum = 0u; cnt = 0u; mine = 0u;
#pragma unroll
    for (unsigned j = 0; j < 16; ++j) { const unsigned c = xb_ld(&bar[XB_XCNT(j)]); sum += c; cnt += (c > 0u) ? 1u : 0u; mine = (j == x) ? c : mine; }
    if (sum == G) break;
    __builtin_amdgcn_s_sleep(1);
    if ((++sp & 255u) == 0u) { if (xb_ld(&bar[XB_TMO])) break; if (sp > XB_SPIN_CAP) { atomicAdd(&bar[XB_TMO], 1u); break; } }
  }
  nloc = mine > 0u ? mine : 1u; nx = cnt > 0u ? cnt : 1u;
}
DEV void xcd_barrier(const XcdBarrier& b) {
  asm volatile("s_waitcnt vmcnt(0)" ::: "memory");
  __syncthreads();
  if (threadIdx.x == 0) {
    unsigned* bar = b.bar;
    __builtin_amdgcn_s_waitcnt(0);
    unsigned nloc = b.st[0], nx = b.st[1];
    if (nloc == 0u) { xcd_barrier_complete(bar, b.x, nloc, nx); b.st[0] = nloc; b.st[1] = nx; }
    const unsigned old = xb_add(&bar[XB_XSUB(b.x)], 1u);
    const unsigned gen = old / nloc;
    if (old + 1u == (gen + 1u) * nloc) {
      __builtin_amdgcn_fence(__ATOMIC_RELEASE, "agent");
      asm volatile("s_waitcnt vmcnt(0)" ::: "memory");
      const unsigned og = xb_add(&bar[XB_TOP], 1u);
      const unsigned tg = og / nx;
      if (og + 1u == (tg + 1u) * nx) xb_add(&bar[XB_TOPGEN], 1u);
      else XB_SPIN(xb_ld(&bar[XB_TOPGEN]) == tg, bar);
      __builtin_amdgcn_fence(__ATOMIC_ACQUIRE, "agent");
      xb_add(&bar[XB_XGEN(b.x)], 1u);
      asm volatile("s_waitcnt vmcnt(0)" ::: "memory");
    } else {
      XB_SPIN(xb_ld(&bar[XB_XGEN(b.x)]) == gen, bar);
      __builtin_amdgcn_fence(__ATOMIC_ACQUIRE, "agent");
      asm volatile("s_waitcnt vmcnt(0)" ::: "memory");
    }
  }
  __syncthreads();
}

__device__ void run_phase(const Params& P, int ph, char* smem, bool do_store) {
  if (ph == 0) { phase_prologue(P); return; }
  const int l = (ph - 1) >> 3, sub = (ph - 1) & 7;
  const int G = gridDim.x, bid = blockIdx.x;
  switch (sub) {
    case 0: gemm_phase256<0>(P, l, P.XB, P.WinT + (size_t)l * NINP * 1024, 19, smem); break;
    case 1: {
      for (int it = bid; it < 512 + 1024; it += G) {
        if (it < 512) compress_block_item(P, l, it, smem);
        else lru_local_item(P, l, it - 512, smem);
        __syncthreads();
      }
    } break;
    case 2: {
      {
        unsigned* qh = P.bar + XCD_BAR_WORDS + l * 8 * 64;
        unsigned* slot = (unsigned*)(smem + 73712);
        for (int qi = 0; qi < 8; ++qi) {
          const int qsel = (bid + qi) & 7;
          for (;;) {
            __syncthreads();
            if (opaque_tid() == 0) *slot = __hip_atomic_fetch_add(&qh[qsel * 64], 1u, __ATOMIC_RELAXED, __HIP_MEMORY_SCOPE_AGENT);
            __syncthreads();
            const unsigned k = *slot;
            if (k >= 128u) break;
            nsa_item(P, l, (int)((127u - k) << 3) | qsel, smem);
          }
        }
        for (;;) {
          __syncthreads();
          if (opaque_tid() == 0) *slot = __hip_atomic_fetch_add(&qh[32], 1u, __ATOMIC_RELAXED, __HIP_MEMORY_SCOPE_AGENT);
          __syncthreads();
          const unsigned k = *slot;
          if (k >= 512u) break;
          lru_final_item(P, l, (int)k);
        }
      }
    } break;
    case 3: gemm_phase256<1>(P, l, P.CAT, P.WoutT + (size_t)l * 1024 * 1024, 8, smem); break;
    case 4: ln1_phase(P, l); break;
    case 5: {
      const int xcd = bid & 7, lb = bid >> 3, nbx = (G - xcd + 7) >> 3;
      for (int lt = lb; lt < 256; lt += nbx) peer_q_topk_item(P, l, xcd * 256 + lt, smem);
    } break;
    case 6: break;
    case 7: peer_gather_phase(P, l, do_store); break;
  }
}

__global__ void __launch_bounds__(256, 2) mega_kernel(Params P, int ph_lo, int ph_hi) {
  __shared__ __attribute__((aligned(16))) char smem[73728];
  __shared__ uint4 xb_words;
  if (threadIdx.x == 0) xb_words = make_uint4(0u, 0u, 0u, 0u);
  __syncthreads();
  XcdBarrier xb = xcd_barrier_post(P.bar, (volatile LAS unsigned*)&xb_words);
  for (int ph = ph_lo; ph < ph_hi; ++ph) {
    const int nrep = (ph == PROBE_DUP) ? 2 : 1;
#pragma unroll 1
    for (int rep = 0; rep < nrep; ++rep) { run_phase(P, ph, smem, rep + 1 == nrep); __syncthreads(); }
    if (ph + 1 < ph_hi) {
      if (ph_hi > 1000) cg::this_grid().sync();
      if (ph == 0 || ((ph - 1) & 7) != 6) xcd_barrier(xb);
    }
  }
}

extern "C" void kernel_launch(void* const* d_in, const int* in_sizes, int n_in, void* d_out, int out_size, void* d_ws, size_t ws_size,
                              hipStream_t stream) {
  Params P{};
  const float* const* in = (const float* const*)d_in;
  P.x = in[0]; P.w_in = in[1]; P.b_in = in[2]; P.conv_w = in[3]; P.conv_b = in[4]; P.lru_wa = in[5]; P.lru_ba = in[6]; P.lru_wx = in[7];
  P.lru_bx = in[8]; P.lru_lambda = in[9]; P.cmp_pos_k = in[10]; P.cmpk_w1 = in[11]; P.cmpk_b1 = in[12]; P.cmpk_w2 = in[13]; P.cmpk_b2 = in[14];
  P.cmp_pos_v = in[15]; P.cmpv_w1 = in[16]; P.cmpv_b1 = in[17]; P.cmpv_w2 = in[18]; P.cmpv_b2 = in[19]; P.gn_lru_g = in[20]; P.gn_nsa_g = in[21];
  P.w_out = in[22]; P.ln1_g = in[23]; P.ln1_b = in[24]; P.peer_wq = in[25]; P.peer_subkeys = in[26]; P.peer_u = in[27]; P.peer_v = in[28];
  P.ln2_g = in[29]; P.ln2_b = in[30];
  P.out = (float*)d_out;
  char* ws = (char*)d_ws; size_t off = 0;
  auto take = [&](size_t bytes) { char* p = ws + off; off += (bytes + 255) & ~(size_t)255; return p; };
  P.WinT = (bf16_t*)take((size_t)2 * NINP * 1024 * 2);
  P.WoutT = (bf16_t*)take((size_t)2 * 1024 * 1024 * 2);
  P.WqT = (bf16_t*)take((size_t)2 * 2048 * 1024 * 2);
  P.SK = (bf16_t*)take((size_t)2 * 2 * 128 * 128 * 2);
  P.W1T = (bf16_t*)take((size_t)4 * 64 * 2048 * 2);
  P.KC = (bf16_t*)take((size_t)8 * 2 * 256 * 64 * 2);
  P.VCT = (bf16_t*)take((size_t)8 * 2 * 64 * 256 * 2);
  P.AP = (float*)take((size_t)8 * 64 * 512 * 4);
  P.HE = (float*)take((size_t)8 * 64 * 512 * 4);
  P.VsT = (bf16_t*)take((size_t)8 * 2 * 64 * 4096 * 2);
  P.VwT = (bf16_t*)take((size_t)8 * 2 * 64 * 4096 * 2);
  P.U8 = (unsigned char*)take((size_t)2 * 16384 * 768);
  P.V8 = (unsigned char*)take((size_t)2 * 16384 * 512);
  P.SU = (float*)take((size_t)2 * 16384 * 4);
  P.SV = (float*)take((size_t)2 * 16384 * 4);
  P.H = (bf16_t*)take((size_t)T_TOK * HS * 2);
  P.QP = P.H;
  P.XB = (bf16_t*)take((size_t)T_TOK * 1024 * 2);
  P.CAT = (bf16_t*)take((size_t)T_TOK * 1024 * 2);
  P.EXP = (int*)P.CAT;
  P.GATE = (float*)((char*)P.CAT + (size_t)T_TOK * 128 * 4);
  P.HL = (bf16_t*)take((size_t)T_TOK * 512 * 2);
  P.PB = (bf16_t*)take((size_t)T_TOK * 512 * 2);
  P.bar = (unsigned*)take((size_t)(XCD_BAR_WORDS + 2 * 8 * 64) * 4);
  P.WgT = (bf16_t*)take((size_t)2 * 8 * 2 * 64 * 64 * 2);
  P.MIX = (bf16_t*)take((size_t)T_TOK * 1024 * 2);
  if (off > ws_size) { fprintf(stderr, "workspace too small: need %zu have %zu\n", off, ws_size); return; }

  static int grid_blocks = 0;
  if (!grid_blocks) {
    int dev = 0, cus = 0, per_cu = 0;
    hipGetDevice(&dev);
    hipDeviceGetAttribute(&cus, hipDeviceAttributeMultiprocessorCount, dev);
    hipOccupancyMaxActiveBlocksPerMultiprocessor(&per_cu, mega_kernel, 256, 0);
    if (per_cu > 2) per_cu = 2;
    if (per_cu < 1) per_cu = 1;
    grid_blocks = cus * per_cu;
  }
  hipMemsetAsync(P.bar, 0, (size_t)(XCD_BAR_WORDS + 2 * 8 * 64) * 4, stream);
#if ONE_LAUNCH
  int lo = 0, hi = NPHASE;
  void* args[] = {&P, &lo, &hi};
  hipError_t e = hipLaunchCooperativeKernel((void*)mega_kernel, dim3(grid_blocks), dim3(256), args, 0, stream);
  if (e != hipSuccess) fprintf(stderr, "cooperative launch failed: %s (grid %d)\n", hipGetErrorString(e), grid_blocks);
#else
  for (int ph = 0; ph < NPHASE; ++ph) {
    hipLaunchKernelGGL(mega_kernel, dim3(grid_blocks), dim3(256), 0, stream, P, ph, ph + 1);
  }
#endif
}
```

```cpp
#include <hip/hip_runtime.h>
#include <hip/hip_cooperative_groups.h>
#include <stdint.h>
#include <stdio.h>
namespace cg = cooperative_groups;

#ifndef ONE_LAUNCH
#define ONE_LAUNCH 1
#ifndef PROBE_DUP
#define PROBE_DUP -100
#endif
#endif

typedef unsigned short bf16_t;
typedef __attribute__((ext_vector_type(8))) short bf16x8;
typedef __attribute__((ext_vector_type(16))) float f32x16;
typedef __attribute__((ext_vector_type(4))) float f32x4;
typedef __bf16 bf16x2_t __attribute__((ext_vector_type(2)));

#define DEV __device__ __forceinline__

constexpr int T_TOK = 32768;
constexpr int SEQ = 4096;
constexpr int NIN = 2328;
constexpr int NINP = 2432;
constexpr int HS = 2072;
constexpr float ALPHA_C = 1.4142135623730951f;
constexpr float EPS_C = 1e-5f;
constexpr int NPHASE = 17;

struct Params {
  const float *x, *w_in, *b_in, *conv_w, *conv_b, *lru_wa, *lru_ba, *lru_wx, *lru_bx, *lru_lambda;
  const float *cmp_pos_k, *cmpk_w1, *cmpk_b1, *cmpk_w2, *cmpk_b2, *cmp_pos_v, *cmpv_w1, *cmpv_b1, *cmpv_w2, *cmpv_b2;
  const float *gn_lru_g, *gn_nsa_g, *w_out, *ln1_g, *ln1_b, *peer_wq, *peer_subkeys, *peer_u, *peer_v, *ln2_g, *ln2_b;
  float* out;
  bf16_t *WinT, *WoutT, *WqT, *SK, *W1T, *KC, *VCT, *VsT, *VwT, *H, *XB, *CAT, *HL, *PB, *QP, *WgT, *MIX;
  unsigned char *U8, *V8;
  float *SU, *SV;
  float *AP, *HE, *GATE;
  int* EXP;
  unsigned* bar;
};

DEV int opaque_tid() { int t = (int)threadIdx.x; asm volatile("" : "+v"(t)); return t; }
typedef float f32x2 __attribute__((ext_vector_type(2)));
DEV unsigned pack2(float a, float b) {
  const f32x2 v = {a, b};
  return __builtin_bit_cast(unsigned, __builtin_convertvector(v, bf16x2_t));
}
DEV unsigned short f2bf(float f) { return (unsigned short)(pack2(f, 0.f) & 0xFFFFu); }
DEV float bf2f(unsigned short h) { return __uint_as_float(((unsigned)h) << 16); }
DEV float lo_f(unsigned w) { return __uint_as_float(w << 16); }
DEV float hi_f(unsigned w) { return __uint_as_float(w & 0xFFFF0000u); }
DEV f32x16 mfma32(bf16x8 a, bf16x8 b, f32x16 c) { return __builtin_amdgcn_mfma_f32_32x32x16_bf16(a, b, c, 0, 0, 0); }
DEV f32x4 mfma16(bf16x8 a, bf16x8 b, f32x4 c) { return __builtin_amdgcn_mfma_f32_16x16x32_bf16(a, b, c, 0, 0, 0); }
DEV float gelu_t(float x) {
  float z = 0.7978845608028654f * (x + 0.044715f * x * x * x);
  float e = __expf(2.f * z);
  float th = 1.f - 2.f / (e + 1.f);
  return 0.5f * x * (1.f + th);
}
DEV float sigmoid_f(float x) { return 1.f / (1.f + __expf(-x)); }
DEV float dpp_row_shr(float v, int n) {
  const int iv = __builtin_bit_cast(int, v); int r;
  switch (n) { case 1: r = __builtin_amdgcn_update_dpp(0, iv, 0x111, 0xf, 0xf, true); break; case 2: r = __builtin_amdgcn_update_dpp(0, iv, 0x112, 0xf, 0xf, true); break;
               case 4: r = __builtin_amdgcn_update_dpp(0, iv, 0x114, 0xf, 0xf, true); break; default: r = __builtin_amdgcn_update_dpp(0, iv, 0x118, 0xf, 0xf, true); break; }
  return __builtin_bit_cast(float, r);
}
DEV float wave_sum(float v) {
  v += dpp_row_shr(v, 1); v += dpp_row_shr(v, 2); v += dpp_row_shr(v, 4); v += dpp_row_shr(v, 8);
  v += __builtin_bit_cast(float, __builtin_amdgcn_update_dpp(0, __builtin_bit_cast(int, v), 0x142, 0xa, 0xf, false));
  v += __builtin_bit_cast(float, __builtin_amdgcn_update_dpp(0, __builtin_bit_cast(int, v), 0x143, 0xc, 0xf, false));
  return __builtin_bit_cast(float, __builtin_amdgcn_readlane(__builtin_bit_cast(int, v), 63));
}
DEV float xor32_f(float v) { return __shfl_xor(v, 32, 64); }
DEV unsigned xor32_u(unsigned v) { return (unsigned)__shfl_xor((int)v, 32, 64); }
DEV bf16x8 pack8(const float* p) {
  uint4 o; o.x = pack2(p[0], p[1]); o.y = pack2(p[2], p[3]); o.z = pack2(p[4], p[5]); o.w = pack2(p[6], p[7]);
  return __builtin_bit_cast(bf16x8, o);
}

__device__ void cvt_job(const float* __restrict__ src, bf16_t* __restrict__ dst, size_t n8, size_t gtid, size_t gsz) {
  for (size_t i = gtid; i < n8; i += gsz) {
    float4 a = ((const float4*)src)[2 * i], b = ((const float4*)src)[2 * i + 1];
    uint4 o; o.x = pack2(a.x, a.y); o.y = pack2(a.z, a.w); o.z = pack2(b.x, b.y); o.w = pack2(b.z, b.w);
    ((uint4*)dst)[i] = o;
  }
}
__device__ void tr_job(const float* __restrict__ src, bf16_t* __restrict__ dst, int K, int Nsrc, int Npad, size_t gtid, size_t gsz) {
  const size_t total = (size_t)Npad * (size_t)(K / 8);
  for (size_t i = gtid; i < total; i += gsz) {
    const int n = (int)(i % (size_t)Npad); const int k8 = (int)(i / (size_t)Npad);
    float v[8];
#pragma unroll
    for (int j = 0; j < 8; ++j) v[j] = (n < Nsrc) ? src[(size_t)(k8 * 8 + j) * Nsrc + n] : 0.f;
    uint4 o; o.x = pack2(v[0], v[1]); o.y = pack2(v[2], v[3]); o.z = pack2(v[4], v[5]); o.w = pack2(v[6], v[7]);
    *(uint4*)(dst + (size_t)n * K + k8 * 8) = o;
  }
}

__device__ void quant_rows(const float* __restrict__ src, unsigned char* __restrict__ dst, float* __restrict__ scl, int nrows) {
  const int tid = opaque_tid(), lane = tid & 63, w = tid >> 6;
  for (int r = blockIdx.x * 4 + w; r < nrows; r += gridDim.x * 4) {
    const float4* p = (const float4*)(src + (size_t)r * 1024 + lane * 16);
    const float4 a = p[0], b = p[1], c = p[2], d = p[3];
    float m = fmaxf(fmaxf(fmaxf(fabsf(a.x), fabsf(a.y)), fmaxf(fabsf(a.z), fabsf(a.w))), fmaxf(fmaxf(fabsf(b.x), fabsf(b.y)), fmaxf(fabsf(b.z), fabsf(b.w))));
    m = fmaxf(m, fmaxf(fmaxf(fmaxf(fabsf(c.x), fabsf(c.y)), fmaxf(fabsf(c.z), fabsf(c.w))), fmaxf(fmaxf(fabsf(d.x), fabsf(d.y)), fmaxf(fabsf(d.z), fabsf(d.w)))));
#pragma unroll
    for (int o = 1; o < 64; o <<= 1) m = fmaxf(m, __shfl_xor(m, o, 64));
    const float sc = (m > 0.f) ? m * (1.f / 256.f) : 1.f;
    const float inv = 1.f / sc;
    uint4 o4; int t;
    t = __builtin_amdgcn_cvt_pk_fp8_f32(a.x * inv, a.y * inv, 0, false); t = __builtin_amdgcn_cvt_pk_fp8_f32(a.z * inv, a.w * inv, t, true); o4.x = (unsigned)t;
    t = __builtin_amdgcn_cvt_pk_fp8_f32(b.x * inv, b.y * inv, 0, false); t = __builtin_amdgcn_cvt_pk_fp8_f32(b.z * inv, b.w * inv, t, true); o4.y = (unsigned)t;
    t = __builtin_amdgcn_cvt_pk_fp8_f32(c.x * inv, c.y * inv, 0, false); t = __builtin_amdgcn_cvt_pk_fp8_f32(c.z * inv, c.w * inv, t, true); o4.z = (unsigned)t;
    t = __builtin_amdgcn_cvt_pk_fp8_f32(d.x * inv, d.y * inv, 0, false); t = __builtin_amdgcn_cvt_pk_fp8_f32(d.z * inv, d.w * inv, t, true); o4.w = (unsigned)t;
    *(uint4*)(dst + (size_t)r * 1024 + lane * 16) = o4;
    if (lane == 0) scl[r] = sc;
  }
}
typedef unsigned v6u_t __attribute__((ext_vector_type(6)));
typedef float v32f_t __attribute__((ext_vector_type(32)));
typedef __bf16 v32bf_t __attribute__((ext_vector_type(32)));
__device__ void quant_rows_fp6(const float* __restrict__ src, unsigned char* __restrict__ dst, float* __restrict__ scl, int nrows) {
  const int tid = opaque_tid(), lane = tid & 63, w = tid >> 6;
  const int l32 = lane & 31, hf = lane >> 5;
  for (int rp = blockIdx.x * 4 + w; rp < nrows / 2; rp += gridDim.x * 4) {
    const int r = rp * 2 + hf;
    const float4* p = (const float4*)(src + (size_t)r * 1024 + l32 * 32);
    float v[32];
#pragma unroll
    for (int i = 0; i < 8; ++i) { const float4 t = p[i]; v[4 * i] = t.x; v[4 * i + 1] = t.y; v[4 * i + 2] = t.z; v[4 * i + 3] = t.w; }
    float m = 0.f;
#pragma unroll
    for (int i = 0; i < 32; ++i) m = fmaxf(m, fabsf(v[i]));
#pragma unroll
    for (int o = 1; o < 32; o <<= 1) m = fmaxf(m, __shfl_xor(m, o, 64));
    const float sc = (m > 0.f) ? m * (1.f / 7.5f) : 1.f;
    const float inv = 1.f / sc;
    v32bf_t bv;
#pragma unroll
    for (int i = 0; i < 32; ++i) bv[i] = (__bf16)(v[i] * inv);
    const v6u_t qv = __builtin_amdgcn_cvt_scalef32_pk32_fp6_bf16(bv, 1.0f);
    uint2* o2 = (uint2*)(dst + (size_t)r * 768 + l32 * 24);
    uint2 t0, t1, t2; t0.x = qv[0]; t0.y = qv[1]; t1.x = qv[2]; t1.y = qv[3]; t2.x = qv[4]; t2.y = qv[5];
    o2[0] = t0; o2[1] = t1; o2[2] = t2;
    if (l32 == 0) scl[r] = sc;
  }
}
__device__ void quant_rows_fp4(const float* __restrict__ src, unsigned char* __restrict__ dst, float* __restrict__ scl, int nrows) {
  const int tid = opaque_tid(), lane = tid & 63, w = tid >> 6;
  for (int r = blockIdx.x * 4 + w; r < nrows; r += gridDim.x * 4) {
    const float4* p = (const float4*)(src + (size_t)r * 1024 + lane * 16);
    const float4 a = p[0], b = p[1], c = p[2], d = p[3];
    float m = fmaxf(fmaxf(fmaxf(fabsf(a.x), fabsf(a.y)), fmaxf(fabsf(a.z), fabsf(a.w))), fmaxf(fmaxf(fabsf(b.x), fabsf(b.y)), fmaxf(fabsf(b.z), fabsf(b.w))));
    m = fmaxf(m, fmaxf(fmaxf(fmaxf(fabsf(c.x), fabsf(c.y)), fmaxf(fabsf(c.z), fabsf(c.w))), fmaxf(fmaxf(fabsf(d.x), fabsf(d.y)), fmaxf(fabsf(d.z), fabsf(d.w)))));
#pragma unroll
    for (int o = 1; o < 64; o <<= 1) m = fmaxf(m, __shfl_xor(m, o, 64));
    const float sc = (m > 0.f) ? m * (1.f / 6.f) : 1.f;
    const float inv = 1.f / sc;
    unsigned q0 = 0u, q1 = 0u;
    q0 = __builtin_amdgcn_cvt_scalef32_pk_fp4_f32(q0, a.x * inv, a.y * inv, 1.0f, 0);
    q0 = __builtin_amdgcn_cvt_scalef32_pk_fp4_f32(q0, a.z * inv, a.w * inv, 1.0f, 1);
    q0 = __builtin_amdgcn_cvt_scalef32_pk_fp4_f32(q0, b.x * inv, b.y * inv, 1.0f, 2);
    q0 = __builtin_amdgcn_cvt_scalef32_pk_fp4_f32(q0, b.z * inv, b.w * inv, 1.0f, 3);
    q1 = __builtin_amdgcn_cvt_scalef32_pk_fp4_f32(q1, c.x * inv, c.y * inv, 1.0f, 0);
    q1 = __builtin_amdgcn_cvt_scalef32_pk_fp4_f32(q1, c.z * inv, c.w * inv, 1.0f, 1);
    q1 = __builtin_amdgcn_cvt_scalef32_pk_fp4_f32(q1, d.x * inv, d.y * inv, 1.0f, 2);
    q1 = __builtin_amdgcn_cvt_scalef32_pk_fp4_f32(q1, d.z * inv, d.w * inv, 1.0f, 3);
    uint2 o2; o2.x = q0; o2.y = q1;
    *(uint2*)(dst + (size_t)r * 512 + lane * 8) = o2;
    if (lane == 0) scl[r] = sc;
  }
}
__device__ void phase_prologue(const Params& P) {
  const size_t gtid = (size_t)blockIdx.x * 256 + opaque_tid(), gsz = (size_t)gridDim.x * 256;
  cvt_job(P.x, P.XB, (size_t)T_TOK * 1024 / 8, gtid, gsz);
  cvt_job(P.peer_subkeys, P.SK, (size_t)2 * 2 * 128 * 128 / 8, gtid, gsz);
  for (int l = 0; l < 2; ++l) {
    tr_job(P.w_in + (size_t)l * 1024 * NIN, P.WinT + (size_t)l * NINP * 1024, 1024, NIN, NINP, gtid, gsz);
    tr_job(P.w_out + (size_t)l * 1024 * 1024, P.WoutT + (size_t)l * 1024 * 1024, 1024, 1024, 1024, gtid, gsz);
    tr_job(P.peer_wq + (size_t)l * 1024 * 2048, P.WqT + (size_t)l * 2048 * 1024, 1024, 2048, 2048, gtid, gsz);
    tr_job(P.cmpk_w1 + (size_t)l * 2048 * 64, P.W1T + (size_t)(l * 2 + 0) * 64 * 2048, 2048, 64, 64, gtid, gsz);
    tr_job(P.cmpv_w1 + (size_t)l * 2048 * 64, P.W1T + (size_t)(l * 2 + 1) * 64 * 2048, 2048, 64, 64, gtid, gsz);
  }
  for (size_t i = gtid; i < (size_t)2 * 8 * 2 * 64 * 8; i += gsz) {
    const int d8 = (int)(i & 7), e = (int)((i >> 3) & 63), mat = (int)((i >> 9) & 1), n = (int)((i >> 10) & 7), l = (int)(i >> 13);
    const float* src = (mat ? P.lru_wx : P.lru_wa) + (size_t)(l * 8 + n) * 4096 + e;
    float v[8];
#pragma unroll
    for (int k = 0; k < 8; ++k) v[k] = src[(size_t)(d8 * 8 + k) * 64];
    uint4 o; o.x = pack2(v[0], v[1]); o.y = pack2(v[2], v[3]); o.z = pack2(v[4], v[5]); o.w = pack2(v[6], v[7]);
    *(uint4*)(P.WgT + ((size_t)((l * 8 + n) * 2 + mat) * 64 + e) * 64 + d8 * 8) = o;
  }
  {
    const size_t n16 = (size_t)2 * 8 * 2 * 256 * 64 * 2 / 16;
    uint4 z; z.x = z.y = z.z = z.w = 0u;
    for (size_t i = gtid; i < n16; i += gsz) ((uint4*)P.KC)[i] = z;
  }
}

DEV void gemm_core(const bf16_t* __restrict__ A, const bf16_t* __restrict__ Bt, int m0, int n0, bf16_t* As, bf16_t* Bs, int tid,
                   f32x16 (&acc)[2][2]) {
  const int lane = tid & 63, w = tid >> 6;
  const int wm = w >> 1, wn = w & 1, lr = lane & 31, hk = lane >> 5;
#pragma unroll
  for (int a = 0; a < 2; ++a)
#pragma unroll
    for (int b = 0; b < 2; ++b)
#pragma unroll
      for (int i = 0; i < 16; ++i) acc[a][b][i] = 0.f;
  uint4 ra0, ra1, ra2, ra3, rb0, rb1, rb2, rb3;
  const int lrow = tid >> 3, lc8 = (tid & 7) * 8;
  const bf16_t* Ap = A + (size_t)(m0 + lrow) * 1024 + lc8;
  const bf16_t* Bp = Bt + (size_t)(n0 + lrow) * 1024 + lc8;
#define GLOAD(k0) { ra0 = *(const uint4*)(Ap + (k0)); ra1 = *(const uint4*)(Ap + 32 * 1024 + (k0)); ra2 = *(const uint4*)(Ap + 64 * 1024 + (k0)); ra3 = *(const uint4*)(Ap + 96 * 1024 + (k0)); \
                    rb0 = *(const uint4*)(Bp + (k0)); rb1 = *(const uint4*)(Bp + 32 * 1024 + (k0)); rb2 = *(const uint4*)(Bp + 64 * 1024 + (k0)); rb3 = *(const uint4*)(Bp + 96 * 1024 + (k0)); }
  GLOAD(0);
  for (int kt = 0; kt < 16; ++kt) {
    __syncthreads();
    {
      bf16_t* as = As + lrow * 72 + lc8; bf16_t* bs = Bs + lrow * 72 + lc8;
      *(uint4*)(as) = ra0; *(uint4*)(as + 32 * 72) = ra1; *(uint4*)(as + 64 * 72) = ra2; *(uint4*)(as + 96 * 72) = ra3;
      *(uint4*)(bs) = rb0; *(uint4*)(bs + 32 * 72) = rb1; *(uint4*)(bs + 64 * 72) = rb2; *(uint4*)(bs + 96 * 72) = rb3;
    }
    __syncthreads();
    {
      const int k0 = (kt + 1 < 16) ? (kt + 1) * 64 : 15 * 64;
      GLOAD(k0);
    }
#pragma unroll
    for (int kk = 0; kk < 4; ++kk) {
      bf16x8 af[2], bfr[2];
#pragma unroll
      for (int mi = 0; mi < 2; ++mi) af[mi] = *(const bf16x8*)(As + (wm * 64 + mi * 32 + lr) * 72 + kk * 16 + hk * 8);
#pragma unroll
      for (int ni = 0; ni < 2; ++ni) bfr[ni] = *(const bf16x8*)(Bs + (wn * 64 + ni * 32 + lr) * 72 + kk * 16 + hk * 8);
#pragma unroll
      for (int mi = 0; mi < 2; ++mi)
#pragma unroll
        for (int ni = 0; ni < 2; ++ni) acc[mi][ni] = mfma32(af[mi], bfr[ni], acc[mi][ni]);
    }
  }
#undef GLOAD
}

template <int EPI>
__device__ void gemm_phase(const Params& P, int l, const bf16_t* __restrict__ A, const bf16_t* __restrict__ Bt, int NT, char* smem) {
  bf16_t* As = (bf16_t*)smem;
  bf16_t* Bs = As + 128 * 72;
  const int tid = opaque_tid(), lane = tid & 63, w = tid >> 6;
  const int wm = w >> 1, wn = w & 1, lr = lane & 31, hk = lane >> 5;
  const int ntiles = 256 * NT;
  for (int tile = blockIdx.x; tile < ntiles; tile += gridDim.x) {
    const int mt = tile / NT, nt = tile - mt * NT;
    const int m0 = mt * 128, n0 = nt * 128;
    f32x16 acc[2][2];
    gemm_core(A, Bt, m0, n0, As, Bs, tid, acc);
#pragma unroll
    for (int mi = 0; mi < 2; ++mi)
#pragma unroll
      for (int ni = 0; ni < 2; ++ni) {
        const int n = n0 + wn * 64 + ni * 32 + lr;
        const int mbase = m0 + wm * 64 + mi * 32 + 4 * hk;
        if (EPI == 0) {
          if (nt == 15 || nt == 17) {
            bf16_t* VT = (nt == 15) ? P.VsT : P.VwT;
            const int nl = n - n0, g = nl >> 6, d = nl & 63;
            const float bias = P.b_in[l * NIN + n];
#pragma unroll
            for (int i4 = 0; i4 < 4; ++i4) {
              const int m = mbase + 8 * i4;
              const int b = m >> 12, s = m & 4095;
              uint2 o;
              o.x = pack2(acc[mi][ni][4 * i4 + 0] + bias, acc[mi][ni][4 * i4 + 1] + bias);
              o.y = pack2(acc[mi][ni][4 * i4 + 2] + bias, acc[mi][ni][4 * i4 + 3] + bias);
              *(uint2*)(VT + ((size_t)((b * 2 + g) * 64 + d)) * 4096 + s) = o;
            }
          } else if (n < NIN) {
            const int hcol = n - (nt == 16 ? 128 : (nt == 18 ? 256 : 0));
            const float bias = P.b_in[l * NIN + n];
#pragma unroll
            for (int i = 0; i < 16; ++i) {
              const int m = mbase + (i & 3) + 8 * (i >> 2);
              P.H[(size_t)m * HS + hcol] = f2bf(acc[mi][ni][i] + bias);
            }
          }
        } else if (EPI == 1) {
#pragma unroll
          for (int i = 0; i < 16; ++i) {
            const int m = mbase + (i & 3) + 8 * (i >> 2);
            P.MIX[(size_t)m * 1024 + n] = f2bf(acc[mi][ni][i]);
          }
        } else {
#pragma unroll
          for (int i = 0; i < 16; ++i) {
            const int m = mbase + (i & 3) + 8 * (i >> 2);
            P.QP[(size_t)m * 2048 + n] = f2bf(acc[mi][ni][i]);
          }
        }
      }
  }
}


template <int EPI>
__device__ void gemm_phase256(const Params& P, int l, const bf16_t* __restrict__ A, const bf16_t* __restrict__ Bt, int NT, char* smem) {
  bf16_t* As = (bf16_t*)smem;
  bf16_t* Bs = As + 256 * 72;
  const int tid = opaque_tid(), lane = tid & 63, w = tid >> 6;
  const int wm = w >> 1, wn = w & 1, lr = lane & 31, hk = lane >> 5;
  const int xcd = blockIdx.x & 7, lb = blockIdx.x >> 3, nbx = ((int)gridDim.x - xcd + 7) >> 3;
  const int nloc = 16 * NT;
  for (int lt = lb; lt < nloc; lt += nbx) {
    const int mtl = lt / NT, nt = lt - mtl * NT;
    const int mt = xcd * 16 + mtl;
    const int m0 = mt * 256, n0 = nt * 128;
    f32x16 acc[4][2];
#pragma unroll
    for (int a = 0; a < 4; ++a)
#pragma unroll
      for (int b = 0; b < 2; ++b)
#pragma unroll
        for (int i = 0; i < 16; ++i) acc[a][b][i] = 0.f;
    uint4 ra0, ra1, ra2, ra3, ra4, ra5, ra6, ra7, rb0, rb1, rb2, rb3;
    const int lrow = tid >> 3, lc8 = (tid & 7) * 8;
    const bf16_t* Ap = A + (size_t)(m0 + lrow) * 1024 + lc8;
    const bf16_t* Bp = Bt + (size_t)(n0 + lrow) * 1024 + lc8;
#define GLOAD2(k0) { ra0 = *(const uint4*)(Ap + (k0)); ra1 = *(const uint4*)(Ap + 32 * 1024 + (k0)); ra2 = *(const uint4*)(Ap + 64 * 1024 + (k0)); ra3 = *(const uint4*)(Ap + 96 * 1024 + (k0)); \
                     ra4 = *(const uint4*)(Ap + 128 * 1024 + (k0)); ra5 = *(const uint4*)(Ap + 160 * 1024 + (k0)); ra6 = *(const uint4*)(Ap + 192 * 1024 + (k0)); ra7 = *(const uint4*)(Ap + 224 * 1024 + (k0)); \
                     rb0 = *(const uint4*)(Bp + (k0)); rb1 = *(const uint4*)(Bp + 32 * 1024 + (k0)); rb2 = *(const uint4*)(Bp + 64 * 1024 + (k0)); rb3 = *(const uint4*)(Bp + 96 * 1024 + (k0)); }
    GLOAD2(0);
    for (int kt = 0; kt < 16; ++kt) {
      __syncthreads();
      {
        bf16_t* as = As + lrow * 72 + lc8; bf16_t* bs = Bs + lrow * 72 + lc8;
        *(uint4*)(as) = ra0; *(uint4*)(as + 32 * 72) = ra1; *(uint4*)(as + 64 * 72) = ra2; *(uint4*)(as + 96 * 72) = ra3;
        *(uint4*)(as + 128 * 72) = ra4; *(uint4*)(as + 160 * 72) = ra5; *(uint4*)(as + 192 * 72) = ra6; *(uint4*)(as + 224 * 72) = ra7;
        *(uint4*)(bs) = rb0; *(uint4*)(bs + 32 * 72) = rb1; *(uint4*)(bs + 64 * 72) = rb2; *(uint4*)(bs + 96 * 72) = rb3;
      }
      __syncthreads();
      {
        const int k0 = (kt + 1 < 16) ? (kt + 1) * 64 : 15 * 64;
        GLOAD2(k0);
      }
#pragma unroll
      for (int kk = 0; kk < 4; ++kk) {
        bf16x8 af[4], bfr[2];
#pragma unroll
        for (int mi = 0; mi < 4; ++mi) af[mi] = *(const bf16x8*)(As + (wm * 128 + mi * 32 + lr) * 72 + kk * 16 + hk * 8);
#pragma unroll
        for (int ni = 0; ni < 2; ++ni) bfr[ni] = *(const bf16x8*)(Bs + (wn * 64 + ni * 32 + lr) * 72 + kk * 16 + hk * 8);
#pragma unroll
        for (int mi = 0; mi < 4; ++mi)
#pragma unroll
          for (int ni = 0; ni < 2; ++ni) acc[mi][ni] = mfma32(af[mi], bfr[ni], acc[mi][ni]);
      }
    }
#undef GLOAD2
    __syncthreads();
    bf16_t* Cs = (bf16_t*)smem;
    const bool vt_tile = (EPI == 0) && (nt == 15 || nt == 17);
    if (vt_tile) {
#pragma unroll
      for (int mi = 0; mi < 4; ++mi)
#pragma unroll
        for (int ni = 0; ni < 2; ++ni) {
          const int d = wn * 64 + ni * 32 + lr;
          const float bias = P.b_in[l * NIN + n0 + d];
          const int rb = wm * 128 + mi * 32 + 4 * hk;
#pragma unroll
          for (int i4 = 0; i4 < 4; ++i4) {
            uint2 o;
            o.x = pack2(acc[mi][ni][4 * i4 + 0] + bias, acc[mi][ni][4 * i4 + 1] + bias);
            o.y = pack2(acc[mi][ni][4 * i4 + 2] + bias, acc[mi][ni][4 * i4 + 3] + bias);
            *(uint2*)(Cs + d * 264 + rb + 8 * i4) = o;
          }
        }
      __syncthreads();
      bf16_t* VT = (nt == 15) ? P.VsT : P.VwT;
      const int bb = m0 >> 12, s0 = m0 & 4095;
#pragma unroll 4
      for (int k = 0; k < 16; ++k) {
        const int c = tid + 256 * k;
        const int d = c >> 5, c8 = (c & 31) * 8;
        const uint4 v = *(const uint4*)(Cs + d * 264 + c8);
        *(uint4*)(VT + ((size_t)((bb * 2 + (d >> 6)) * 64 + (d & 63))) * 4096 + s0 + c8) = v;
      }
    } else {
#pragma unroll
      for (int mi = 0; mi < 4; ++mi)
#pragma unroll
        for (int ni = 0; ni < 2; ++ni) {
          const int col = wn * 64 + ni * 32 + lr;
          const int n = n0 + col;
          const float bias = (EPI == 0) ? ((n < NIN) ? P.b_in[l * NIN + n] : 0.f) : 0.f;
          const int rb = wm * 128 + mi * 32 + 4 * hk;
#pragma unroll
          for (int i = 0; i < 16; ++i) Cs[(rb + (i & 3) + 8 * (i >> 2)) * 136 + col] = f2bf(acc[mi][ni][i] + bias);
        }
      __syncthreads();
      bf16_t* dstb; int dstride, cbase, nvalid;
      if (EPI == 0) { dstb = P.H; dstride = HS; cbase = n0 - (nt == 16 ? 128 : (nt == 18 ? 256 : 0)); nvalid = (NIN - n0 < 128) ? (NIN - n0) : 128; }
      else { dstb = P.MIX; dstride = 1024; cbase = n0; nvalid = 128; }
#pragma unroll 4
      for (int k = 0; k < 16; ++k) {
        const int c = tid + 256 * k;
        const int row = c >> 4, c8 = (c & 15) * 8;
        if (c8 < nvalid) {
          const uint4 v = *(const uint4*)(Cs + row * 136 + c8);
          *(uint4*)(dstb + (size_t)(m0 + row) * dstride + cbase + c8) = v;
        }
      }
    }
  }
}

__device__ void lru_local_item(const Params& P, int l, int item, char* smem) {
  float* xs = (float*)smem;
  bf16_t* xb = (bf16_t*)(smem + 16384);
  const int tid = opaque_tid(), lane = tid & 63, w = tid >> 6;
  float* cs = (float*)(smem + 25088) + w * 2048;
  const int half = item & 1, j = (item >> 1) & 63, b = item >> 7;
  const int ch = half * 256 + tid, n = ch >> 6;
  const int r16 = lane & 15, kq = lane >> 4;
  bf16x8 bw[2][4][2];
  {
    const bf16_t* wt = P.WgT + (size_t)(l * 8 + n) * 2 * 4096;
#pragma unroll
    for (int mat = 0; mat < 2; ++mat)
#pragma unroll
      for (int nt = 0; nt < 4; ++nt)
#pragma unroll
        for (int ks = 0; ks < 2; ++ks) bw[mat][nt][ks] = *(const bf16x8*)(wt + mat * 4096 + (nt * 16 + r16) * 64 + ks * 32 + kq * 8);
  }
  const float cw0 = P.conv_w[l * 4 * 512 + 0 * 512 + ch], cw1 = P.conv_w[l * 4 * 512 + 1 * 512 + ch];
  const float cw2 = P.conv_w[l * 4 * 512 + 2 * 512 + ch], cw3 = P.conv_w[l * 4 * 512 + 3 * 512 + ch];
  const float cb = P.conv_b[l * 512 + ch], ba = P.lru_ba[l * 512 + ch], bx = P.lru_bx[l * 512 + ch];
  const float lam = P.lru_lambda[l * 512 + ch];
  const float z = -lam;
  const float sp = fmaxf(z, 0.f) + log1pf(__expf(-fabsf(z)));
  const float nl = -8.0f * sp;
  const int s0 = j * 64;
  const bf16_t* hx = P.H + (size_t)(b * SEQ) * HS + ch;
  float xm3 = (s0 - 3 >= 0) ? bf2f(hx[(size_t)(s0 - 3) * HS]) : 0.f;
  float xm2 = (s0 - 2 >= 0) ? bf2f(hx[(size_t)(s0 - 2) * HS]) : 0.f;
  float xm1 = (s0 - 1 >= 0) ? bf2f(hx[(size_t)(s0 - 1) * HS]) : 0.f;
  float h = 0.f, pc = 1.f;
  unsigned short hv[16], hn[16];
#pragma unroll
  for (int i = 0; i < 16; ++i) { hv[i] = hx[(size_t)(s0 + i) * HS]; hn[i] = hv[i]; }
#pragma unroll 1
  for (int sub = 0; sub < 4; ++sub) {
    __syncthreads();
#pragma unroll
    for (int i = 0; i < 16; ++i) {
      const float xv = bf2f(hv[i]);
      const float xc = cb + cw0 * xm3 + cw1 * xm2 + cw2 * xm1 + cw3 * xv;
      xm3 = xm2; xm2 = xm1; xm1 = xv;
      xs[i * 256 + tid] = xc;
      xb[i * 264 + tid] = f2bf(xc);
    }
    __syncthreads();
    {
      bf16x8 af[2];
#pragma unroll
      for (int ks = 0; ks < 2; ++ks) af[ks] = *(const bf16x8*)(xb + r16 * 264 + w * 64 + ks * 32 + kq * 8);
#pragma unroll
      for (int mat = 0; mat < 2; ++mat)
#pragma unroll
        for (int nt = 0; nt < 4; ++nt) {
          f32x4 acc = {0.f, 0.f, 0.f, 0.f};
          acc = mfma16(af[0], bw[mat][nt][0], acc);
          acc = mfma16(af[1], bw[mat][nt][1], acc);
#pragma unroll
          for (int r = 0; r < 4; ++r) cs[mat * 1024 + (kq * 4 + r) * 64 + nt * 16 + r16] = acc[r];
        }
    }
    {
      const int sn = s0 + ((sub < 3) ? (sub + 1) * 16 : sub * 16);
#pragma unroll
      for (int i = 0; i < 16; ++i) hn[i] = hx[(size_t)(sn + i) * HS];
    }
    __syncthreads();
#pragma unroll 4
    for (int i = 0; i < 16; ++i) {
      const int s = s0 + sub * 16 + i;
      const float ra = cs[i * 64 + lane] + ba, ri = cs[1024 + i * 64 + lane] + bx;
      const float r = sigmoid_f(ra), ig = sigmoid_f(ri);
      const float la = r * nl;
      const float a = __expf(la);
      const float uu = sqrtf(fmaxf(1.f - a * a, 0.f)) * (ig * xs[i * 256 + tid]);
      h = a * h + uu; pc *= a;
      const size_t o = (size_t)(b * SEQ + s) * 512 + ch;
      P.HL[o] = f2bf(h); P.PB[o] = f2bf(pc);
    }
#pragma unroll
    for (int i = 0; i < 16; ++i) hv[i] = hn[i];
  }
  P.AP[(size_t)(b * 64 + j) * 512 + ch] = pc;
  P.HE[(size_t)(b * 64 + j) * 512 + ch] = h;
}

__device__ void compress_block_item(const Params& P, int l, int bitem, char* smem) {
  const int tid = opaque_tid(), lane = tid & 63, w = tid >> 6;
  float* part = (float*)smem;
  float* hid = (float*)smem + 4096;
  const int wi = bitem;
  const int rt = wi & 127, g = (wi >> 7) & 1, kv = wi >> 8;
  const int r16 = lane & 15, kq = lane >> 4;
  const int row = rt * 16 + r16, rowc = row < 2040 ? row : 2039;
  const int b = rowc / 255, n = rowc - b * 255;
  const bf16_t* src = P.H + (size_t)(b * SEQ + n * 16) * HS + (kv ? 1664 : 1536) + g * 64;
  const float* pos = (kv ? P.cmp_pos_v : P.cmp_pos_k) + l * 32 * 64;
  const bf16_t* W1T = P.W1T + (size_t)(l * 2 + kv) * 64 * 2048;
  f32x4 acc[4];
#pragma unroll
  for (int a = 0; a < 4; ++a) { acc[a][0] = 0.f; acc[a][1] = 0.f; acc[a][2] = 0.f; acc[a][3] = 0.f; }
#pragma unroll 4
  for (int k2 = 0; k2 < 16; ++k2) {
    const int ks = w * 16 + k2;
    const int tl = ks >> 1, d0 = (ks & 1) * 32 + kq * 8;
    const uint4 raw = *(const uint4*)(src + (size_t)tl * HS + d0);
    const float4 p0 = *(const float4*)(pos + tl * 64 + d0), p1 = *(const float4*)(pos + tl * 64 + d0 + 4);
    float v[8];
    v[0] = lo_f(raw.x) + p0.x; v[1] = hi_f(raw.x) + p0.y; v[2] = lo_f(raw.y) + p0.z; v[3] = hi_f(raw.y) + p0.w;
    v[4] = lo_f(raw.z) + p1.x; v[5] = hi_f(raw.z) + p1.y; v[6] = lo_f(raw.w) + p1.z; v[7] = hi_f(raw.w) + p1.w;
    const bf16x8 af = pack8(v);
#pragma unroll
    for (int nt = 0; nt < 4; ++nt) {
      const bf16x8 bfr = *(const bf16x8*)(W1T + (size_t)(nt * 16 + r16) * 2048 + ks * 32 + kq * 8);
      acc[nt] = mfma16(af, bfr, acc[nt]);
    }
  }
  const float* b1 = (kv ? P.cmpv_b1 : P.cmpk_b1) + l * 64;
  const float* w2 = (kv ? P.cmpv_w2 : P.cmpk_w2) + l * 64 * 64;
  const float* b2 = (kv ? P.cmpv_b2 : P.cmpk_b2) + l * 64;
  __syncthreads();
#pragma unroll
  for (int nt = 0; nt < 4; ++nt)
#pragma unroll
    for (int r = 0; r < 4; ++r) part[w * 1024 + (kq * 4 + r) * 64 + nt * 16 + r16] = acc[nt][r];
  __syncthreads();
#pragma unroll
  for (int k = 0; k < 4; ++k) {
    const int idx = tid + 256 * k;
    const float sum = part[idx] + part[1024 + idx] + part[2048 + idx] + part[3072 + idx];
    hid[idx] = gelu_t(sum + b1[idx & 63]);
  }
  __syncthreads();
  float w2c[64];
#pragma unroll
  for (int k = 0; k < 64; ++k) w2c[k] = w2[k * 64 + lane];
  const float bo = b2[lane];
#pragma unroll 1
  for (int r4 = 0; r4 < 4; ++r4) {
    const int rr = w * 4 + r4;
    float o = bo;
    const float4* hp = (const float4*)(hid + rr * 64);
#pragma unroll
    for (int k4 = 0; k4 < 16; ++k4) {
      const float4 hv = hp[k4];
      o += hv.x * w2c[4 * k4] + hv.y * w2c[4 * k4 + 1] + hv.z * w2c[4 * k4 + 2] + hv.w * w2c[4 * k4 + 3];
    }
    const int row2 = rt * 16 + rr;
    if (row2 < 2040) {
      const int b2i = row2 / 255, n2 = row2 - b2i * 255;
      if (kv == 0) P.KC[((size_t)((b2i * 2 + g) * 256 + n2)) * 64 + lane] = f2bf(o);
      else P.VCT[((size_t)((b2i * 2 + g) * 64 + lane)) * 256 + n2] = f2bf(o);
    }
  }
}

__device__ void lru_final_item(const Params& P, int l, int item) {
  const int tid = opaque_tid(), lane = tid & 63, w = tid >> 6;
  const int j = item & 63, b = item >> 6;
  float carry[8];
#pragma unroll
  for (int k = 0; k < 8; ++k) carry[k] = 0.f;
  for (int jj = 0; jj < j; ++jj) {
    const float* ap = P.AP + (size_t)(b * 64 + jj) * 512 + lane * 8;
    const float* he = P.HE + (size_t)(b * 64 + jj) * 512 + lane * 8;
    const float4 a0 = *(const float4*)ap, a1 = *(const float4*)(ap + 4);
    const float4 h0 = *(const float4*)he, h1 = *(const float4*)(he + 4);
    carry[0] = a0.x * carry[0] + h0.x; carry[1] = a0.y * carry[1] + h0.y; carry[2] = a0.z * carry[2] + h0.z; carry[3] = a0.w * carry[3] + h0.w;
    carry[4] = a1.x * carry[4] + h1.x; carry[5] = a1.y * carry[5] + h1.y; carry[6] = a1.z * carry[6] + h1.z; carry[7] = a1.w * carry[7] + h1.w;
  }
  const float* gg = P.gn_lru_g + l * 512 + lane * 8;
  const float4 g0 = *(const float4*)gg, g1 = *(const float4*)(gg + 4);
  const float gw[8] = {g0.x, g0.y, g0.z, g0.w, g1.x, g1.y, g1.z, g1.w};
  for (int i = 0; i < 16; ++i) {
    const int s = j * 64 + w + 4 * i;
    const size_t tok = (size_t)(b * SEQ + s);
    const uint4 hl = *(const uint4*)(P.HL + tok * 512 + lane * 8);
    const uint4 pb = *(const uint4*)(P.PB + tok * 512 + lane * 8);
    const uint4 gt = *(const uint4*)(P.H + tok * HS + 512 + lane * 8);
    const unsigned hw[4] = {hl.x, hl.y, hl.z, hl.w}, pw[4] = {pb.x, pb.y, pb.z, pb.w}, gx[4] = {gt.x, gt.y, gt.z, gt.w};
    float y[8]; float ss = 0.f;
#pragma unroll
    for (int k2 = 0; k2 < 4; ++k2) {
      const float h0 = lo_f(hw[k2]) + lo_f(pw[k2]) * carry[2 * k2];
      const float h1 = hi_f(hw[k2]) + hi_f(pw[k2]) * carry[2 * k2 + 1];
      y[2 * k2] = h0 * gelu_t(lo_f(gx[k2]));
      y[2 * k2 + 1] = h1 * gelu_t(hi_f(gx[k2]));
      ss += y[2 * k2] * y[2 * k2] + y[2 * k2 + 1] * y[2 * k2 + 1];
    }
    ss = wave_sum(ss);
    const float rs = rsqrtf(ss * (1.f / 512.f) + EPS_C);
    float o[8];
#pragma unroll
    for (int k = 0; k < 8; ++k) o[k] = y[k] * rs * gw[k];
    *(bf16x8*)(P.CAT + tok * 1024 + lane * 8) = pack8(o);
  }
}

DEV int kperm(int m) { return (m & 0x13) | ((m & 4) << 1) | ((m & 8) >> 1); }

struct AttAcc { f32x16 o0, o1; float m, l; };

DEV f32x16 qk_tile(const bf16_t* krow, const bf16x8 (&qf)[4]) {
  f32x16 s;
#pragma unroll
  for (int i = 0; i < 16; ++i) s[i] = 0.f;
#pragma unroll
  for (int ks = 0; ks < 4; ++ks) {
    const bf16x8 a = *(const bf16x8*)(krow + ks * 16);
    s = mfma32(a, qf[ks], s);
  }
  return s;
}
DEV void load_kfrag(bf16x8 (&kf)[4], const bf16_t* krow) {
#pragma unroll
  for (int ks = 0; ks < 4; ++ks) kf[ks] = *(const bf16x8*)(krow + ks * 16);
}
DEV f32x16 qk_regs(const bf16x8 (&kf)[4], const bf16x8 (&qf)[4]) {
  f32x16 s;
#pragma unroll
  for (int i = 0; i < 16; ++i) s[i] = 0.f;
#pragma unroll
  for (int ks = 0; ks < 4; ++ks) s = mfma32(kf[ks], qf[ks], s);
  return s;
}
DEV void pv_tile(f32x16& o0, f32x16& o1, const bf16_t* vt, size_t vstride, const float* p) {
  const bf16x8 pf0 = pack8(p), pf1 = pack8(p + 8);
  const bf16x8 a00 = *(const bf16x8*)(vt), a01 = *(const bf16x8*)(vt + 16);
  const bf16x8 a10 = *(const bf16x8*)(vt + 32 * vstride), a11 = *(const bf16x8*)(vt + 32 * vstride + 16);
  o0 = mfma32(a00, pf0, o0); o0 = mfma32(a01, pf1, o0);
  o1 = mfma32(a10, pf0, o1); o1 = mfma32(a11, pf1, o1);
}
DEV void att_tile(AttAcc& A, const f32x16& s, float qs, float slope2, int dt, float lane_bias, bool masked, int wlim,
                  const bf16_t* vt, size_t vstride) {
  const float sb = slope2 * (float)dt + lane_bias;
  float sc[16];
#pragma unroll
  for (int i = 0; i < 16; ++i) {
    const float ci = (float)((i & 7) + 16 * (i >> 3));
    sc[i] = fmaf(s[i], qs, fmaf(slope2, ci, -sb));
  }
  if (masked) {
#pragma unroll
    for (int i = 0; i < 16; ++i) {
      const int di = dt - ((i & 7) + 16 * (i >> 3));
      sc[i] = (di >= 0 && di < wlim) ? sc[i] : -3.0e38f;
    }
  }
  float tmax = sc[0];
#pragma unroll
  for (int i = 1; i < 16; ++i) tmax = fmaxf(tmax, sc[i]);
  tmax = fmaxf(tmax, xor32_f(tmax));
  if (__any(tmax > A.m)) {
    const float mnew = fmaxf(A.m, tmax);
    const float alpha = __builtin_amdgcn_exp2f(A.m - mnew);
    A.m = mnew;
    A.l *= alpha;
#pragma unroll
    for (int i = 0; i < 16; ++i) { A.o0[i] *= alpha; A.o1[i] *= alpha; }
  }
  float p[16]; float ps = 0.f;
#pragma unroll
  for (int i = 0; i < 16; ++i) { p[i] = __builtin_amdgcn_exp2f(sc[i] - A.m); ps += p[i]; }
  A.l += ps;
  pv_tile(A.o0, A.o1, vt, vstride, p);
}

DEV void att_tile64(AttAcc& A, const f32x16& s0, const f32x16& s1, float qs, float slope2, int dt, float lane_bias, bool masked, int wlim,
                    const bf16_t* vt, size_t vstride) {
  const float sb = slope2 * (float)dt + lane_bias;
  float sc[32];
#pragma unroll
  for (int i = 0; i < 16; ++i) {
    const int c = (i & 7) + 16 * (i >> 3);
    sc[i] = fmaf(s0[i], qs, fmaf(slope2, (float)c, -sb));
    sc[16 + i] = fmaf(s1[i], qs, fmaf(slope2, (float)(c + 32), -sb));
  }
  if (masked) {
#pragma unroll
    for (int i = 0; i < 32; ++i) {
      const int c = (i & 7) + 16 * ((i & 15) >> 3) + 32 * (i >> 4);
      const int di = dt - c;
      sc[i] = (di >= 0 && di < wlim) ? sc[i] : -3.0e38f;
    }
  }
  float tmax = sc[0];
#pragma unroll
  for (int i = 1; i < 32; ++i) tmax = fmaxf(tmax, sc[i]);
  tmax = fmaxf(tmax, xor32_f(tmax));
  if (__any(tmax > A.m)) {
    const float mnew = fmaxf(A.m, tmax);
    const float alpha = __builtin_amdgcn_exp2f(A.m - mnew);
    A.m = mnew;
    A.l *= alpha;
#pragma unroll
    for (int i = 0; i < 16; ++i) { A.o0[i] *= alpha; A.o1[i] *= alpha; }
  }
  float p[32]; float ps = 0.f;
#pragma unroll
  for (int i = 0; i < 32; ++i) { p[i] = __builtin_amdgcn_exp2f(sc[i] - A.m); ps += p[i]; }
  A.l += ps;
  pv_tile(A.o0, A.o1, vt, vstride, p);
  pv_tile(A.o0, A.o1, vt + 32, vstride, p + 16);
}

__device__ void nsa_item(const Params& P, int l, int item, char* smem) {
  const int b = item & 7, qt = item >> 3;
  const int t0 = qt * 32, cur = t0 >> 6;
  float* imp = (float*)smem;
  float* yacc = (float*)smem;
  float* ssq = (float*)(smem + 32768);
  unsigned char* selb = (unsigned char*)(smem + 33792);
  bf16_t* kvs = (bf16_t*)(smem + 34816);
  unsigned ykeep[16];
#pragma unroll
  for (int i = 0; i < 16; ++i) ykeep[i] = 0u;
  const bf16_t* Hb = P.H + (size_t)(b * SEQ) * HS;
#pragma unroll 1
  for (int g = 0; g < 2; ++g) {
    const int tid = opaque_tid(), lane = tid & 63, w = tid >> 6;
    const int q = lane & 31, hk = lane >> 5;
    const int t = t0 + q;
    const int km = kperm(q);
    float* yown = yacc + (w * 64 + 4 * hk) * 32 + q;
    const int head = g * 4 + w;
    const float slope = exp2f(-(float)(head + 1));
    bf16x8 qf[4];
    {
      const bf16_t* qrow = Hb + (size_t)t * HS + 1024 + head * 64 + hk * 8;
#pragma unroll
      for (int ks = 0; ks < 4; ++ks) qf[ks] = *(const bf16x8*)(qrow + ks * 16);
    }
    const bf16_t* grow = Hb + (size_t)t * HS + 2048 + head * 3;
    const float gc = sigmoid_f(bf2f(grow[0])), gs = sigmoid_f(bf2f(grow[1])), gwn = sigmoid_f(bf2f(grow[2]));
    const bf16_t* KCb = P.KC + (size_t)((b * 2 + g) * 256) * 64;
    const bf16_t* VCb = P.VCT + (size_t)((b * 2 + g) * 64) * 256;
    const int cmaxi = (2 * qt < 254) ? 2 * qt : 254;
    const int ntc = (cmaxi >> 5) + 1;
    float cm = -1e30f, cinv = 0.f;
    {
      float lsum = 0.f;
      bf16x8 kf[4], kn[4];
      load_kfrag(kf, KCb + (size_t)km * 64 + hk * 8);
#pragma unroll 1
      for (int kt = 0; kt < ntc; ++kt) {
        load_kfrag(kn, KCb + (size_t)(((kt + 1 < ntc) ? kt + 1 : kt) * 32 + km) * 64 + hk * 8);
        const f32x16 s = qk_regs(kf, qf);
#pragma unroll
        for (int ks = 0; ks < 4; ++ks) kf[ks] = kn[ks];
        float sv[16]; float tmax = -1e30f;
#pragma unroll
        for (int i = 0; i < 16; ++i) {
          const int c = kt * 32 + (i & 7) + 8 * hk + 16 * (i >> 3);
          const int dist = t - (16 * c + 31);
          sv[i] = (dist >= 0) ? (s[i] * 0.125f - slope * (float)dist) : -1e30f;
          tmax = fmaxf(tmax, sv[i]);
        }
        tmax = fmaxf(tmax, xor32_f(tmax));
        const float mnew = fmaxf(cm, tmax);
        float ps = 0.f;
#pragma unroll
        for (int i = 0; i < 16; ++i) ps += (sv[i] > -1e29f) ? __expf(sv[i] - mnew) : 0.f;
        lsum = lsum * __expf(cm - mnew) + ps;
        cm = mnew;
      }
      lsum += xor32_f(lsum);
      cinv = (lsum > 0.f) ? 1.f / lsum : 0.f;
    }
    f32x16 co0, co1;
#pragma unroll
    for (int i = 0; i < 16; ++i) { co0[i] = 0.f; co1[i] = 0.f; }
    {
      float carry15 = 0.f;
      bf16x8 kf[4], kn[4];
      load_kfrag(kf, KCb + (size_t)km * 64 + hk * 8);
#pragma unroll 1
      for (int kt = 0; kt < ntc; ++kt) {
        load_kfrag(kn, KCb + (size_t)(((kt + 1 < ntc) ? kt + 1 : kt) * 32 + km) * 64 + hk * 8);
        const f32x16 s = qk_regs(kf, qf);
#pragma unroll
        for (int ks = 0; ks < 4; ++ks) kf[ks] = kn[ks];
        float p[16];
#pragma unroll
        for (int i = 0; i < 16; ++i) {
          const int c = kt * 32 + (i & 7) + 8 * hk + 16 * (i >> 3);
          const int dist = t - (16 * c + 31);
          p[i] = (dist >= 0) ? __expf(s[i] * 0.125f - slope * (float)dist - cm) * cinv : 0.f;
        }
        const float x7 = xor32_f(p[7]), x15 = xor32_f(p[15]);
        const float prev0 = hk ? x7 : carry15;
        const float prev2 = hk ? x15 : x7;
        carry15 = x15;
        float* ib = imp + (w * 32 + q) * 64 + 8 * kt + 2 * hk;
        ib[0] = 2.f * (p[0] + p[1] + p[2]) + p[3] + prev0;
        ib[1] = 2.f * (p[4] + p[5] + p[6]) + p[7] + p[3];
        ib[4] = 2.f * (p[8] + p[9] + p[10]) + p[11] + prev2;
        ib[5] = 2.f * (p[12] + p[13] + p[14]) + p[15] + p[11];
        pv_tile(co0, co1, VCb + (size_t)q * 256 + kt * 32 + 8 * hk, 256, p);
      }
    }
    __syncthreads();
    {
      const int q2 = tid >> 3, js = tid & 7;
#pragma unroll
      for (int jj = 0; jj < 8; ++jj) {
        const int j = js * 8 + jj;
        float v = imp[(0 * 32 + q2) * 64 + j] + imp[(1 * 32 + q2) * 64 + j] + imp[(2 * 32 + q2) * 64 + j] + imp[(3 * 32 + q2) * 64 + j];
        if (j <= cur) { if (j == 0 || j == cur || j == cur - 1) v += 1e4f; }
        else v = -1e30f;
        imp[q2 * 64 + j] = v;
      }
      __syncthreads();
      float mine[8];
#pragma unroll
      for (int jj = 0; jj < 8; ++jj) mine[jj] = imp[q2 * 64 + js * 8 + jj];
      int cnt[8];
#pragma unroll
      for (int jj = 0; jj < 8; ++jj) cnt[jj] = 0;
#pragma unroll 4
      for (int j2 = 0; j2 < 64; ++j2) {
        const float v2 = imp[q2 * 64 + j2];
#pragma unroll
        for (int jj = 0; jj < 8; ++jj) {
          const int j = js * 8 + jj;
          cnt[jj] += ((v2 > mine[jj]) || (v2 == mine[jj] && j2 < j)) ? 1 : 0;
        }
      }
      unsigned bits = 0;
#pragma unroll
      for (int jj = 0; jj < 8; ++jj) bits |= (cnt[jj] < 16 ? 1u : 0u) << jj;
      selb[q2 * 8 + js] = (unsigned char)bits;
    }
    __syncthreads();
    const uint2 selw = *(const uint2*)(selb + q * 8);
    const unsigned long long selmask = (unsigned long long)selw.x | ((unsigned long long)selw.y << 32);

#pragma unroll
    for (int i = 0; i < 16; ++i) {
      yown[((i & 3) + 8 * (i >> 2)) * 32] = gc * co0[i];
      yown[(32 + (i & 3) + 8 * (i >> 2)) * 32] = gc * co1[i];
    }
    const float qs2 = 0.125f * 1.4426950408889634f, slope2 = slope * 1.4426950408889634f;
    float ss = 0.f;
#pragma unroll 1
    for (int br = 0; br < 2; ++br) {
      AttAcc A;
#pragma unroll
      for (int i = 0; i < 16; ++i) { A.o0[i] = 0.f; A.o1[i] = 0.f; }
      A.m = -1e30f; A.l = 0.f;
      const bf16_t* Kg = Hb + (br == 0 ? 1792 : 1920) + g * 64;
      const bf16_t* VTg = (br == 0 ? P.VsT : P.VwT) + (size_t)((b * 2 + g) * 64) * 4096;
      const int khi = t0 & ~63;
      const int klo = (br == 0) ? 0 : (((t0 - 512 > 0) ? (t0 - 512) : 0) & ~63);
      const int ntile = ((khi - klo) >> 6) + 1;
      const int wlim = (br == 0) ? (1 << 30) : 512;
      const int srow = tid >> 3, sc8 = (tid & 7) * 8;
      const int koff = kperm(srow) * 72 + sc8, voff = 4608 + srow * 72 + sc8;
      const bf16_t* kgp = Kg + (size_t)srow * HS + sc8;
      const bf16_t* vgp = VTg + (size_t)srow * 4096 + sc8;
      uint4 rk0, rk1, rv0, rv1;
      rk0 = *(const uint4*)(kgp + (size_t)khi * HS); rk1 = *(const uint4*)(kgp + (size_t)(khi + 32) * HS);
      rv0 = *(const uint4*)(vgp + khi); rv1 = *(const uint4*)(vgp + (size_t)32 * 4096 + khi);
      *(uint4*)(kvs + koff) = rk0; *(uint4*)(kvs + koff + 32 * 72) = rk1;
      *(uint4*)(kvs + voff) = rv0; *(uint4*)(kvs + voff + 32 * 72) = rv1;
      __syncthreads();
#pragma unroll 1
      for (int i = 0; i < ntile; ++i) {
        const int kb = khi - 64 * i;
        const bool more = (i + 1 < ntile);
        if (more) {
          rk0 = *(const uint4*)(kgp + (size_t)(kb - 64) * HS); rk1 = *(const uint4*)(kgp + (size_t)(kb - 32) * HS);
          rv0 = *(const uint4*)(vgp + kb - 64); rv1 = *(const uint4*)(vgp + (size_t)32 * 4096 + kb - 64);
        }
        const bf16_t* buf = kvs + (i & 1) * 9216;
        f32x16 s0, s1;
#pragma unroll
        for (int e = 0; e < 16; ++e) { s0[e] = 0.f; s1[e] = 0.f; }
        {
          const bf16_t* kl = buf + q * 72 + hk * 8;
#pragma unroll
          for (int ks = 0; ks < 4; ++ks) {
            s0 = mfma32(*(const bf16x8*)(kl + ks * 16), qf[ks], s0);
            s1 = mfma32(*(const bf16x8*)(kl + 32 * 72 + ks * 16), qf[ks], s1);
          }
        }
        float lane_bias = 0.f;
        if (br == 0) { const bool selj = (selmask >> (kb >> 6)) & 1ull; lane_bias = selj ? 0.f : 1e30f; }
        const bool masked = (kb + 63 > t0) || (br == 1 && kb <= t0 - 481);
        att_tile64(A, s0, s1, qs2, slope2, t - kb - 8 * hk, lane_bias, masked, wlim, buf + 4608 + q * 72 + 8 * hk, 72);
        if (more) {
          bf16_t* nb = kvs + ((i + 1) & 1) * 9216;
          *(uint4*)(nb + koff) = rk0; *(uint4*)(nb + koff + 32 * 72) = rk1;
          *(uint4*)(nb + voff) = rv0; *(uint4*)(nb + voff + 32 * 72) = rv1;
        }
        __syncthreads();
      }
      const float lt = A.l + xor32_f(A.l);
      const float sc = (lt > 0.f) ? (br == 0 ? gs : gwn) / lt : 0.f;
      if (br == 0) {
#pragma unroll
        for (int i = 0; i < 16; ++i) {
          yown[((i & 3) + 8 * (i >> 2)) * 32] += sc * A.o0[i];
          yown[(32 + (i & 3) + 8 * (i >> 2)) * 32] += sc * A.o1[i];
        }
      } else {
        float y0[16], y1[16];
#pragma unroll
        for (int i = 0; i < 16; ++i) {
          const int d0 = (i & 3) + 8 * (i >> 2);
          y0[i] = yown[d0 * 32] + sc * A.o0[i];
          y1[i] = yown[(32 + d0) * 32] + sc * A.o1[i];
          ss += y0[i] * y0[i] + y1[i] * y1[i];
        }
        if (g == 0) {
#pragma unroll
          for (int i2 = 0; i2 < 8; ++i2) { ykeep[i2] = pack2(y0[2 * i2], y0[2 * i2 + 1]); ykeep[8 + i2] = pack2(y1[2 * i2], y1[2 * i2 + 1]); }
        } else {
#pragma unroll
          for (int i = 0; i < 16; ++i) {
            const int d0 = (i & 3) + 8 * (i >> 2);
            yown[d0 * 32] = y0[i];
            yown[(32 + d0) * 32] = y1[i];
          }
        }
      }
    }
    ss += xor32_f(ss);
    if (hk == 0) ssq[q * 8 + head] = ss;
    __syncthreads();
  }
  {
    const float* gn = P.gn_nsa_g + l * 512;
    const int tid = opaque_tid(), lane = tid & 63, w = tid >> 6;
    {
      const int q = lane & 31, hk = lane >> 5;
      float tot = 0.f;
#pragma unroll
      for (int hh = 0; hh < 8; ++hh) tot += ssq[q * 8 + hh];
      const float rs = rsqrtf(tot * (1.f / 512.f) + EPS_C);
      bf16_t* dst = P.CAT + (size_t)(b * SEQ + t0 + q) * 1024 + 512 + w * 64;
      const float* gh = gn + w * 64;
#pragma unroll
      for (int i4 = 0; i4 < 4; ++i4) {
        const int d = 8 * i4 + 4 * hk;
        const float4 ga = *(const float4*)(gh + d), gb = *(const float4*)(gh + 32 + d);
        uint2 o;
        o.x = pack2(lo_f(ykeep[2 * i4]) * rs * ga.x, hi_f(ykeep[2 * i4]) * rs * ga.y);
        o.y = pack2(lo_f(ykeep[2 * i4 + 1]) * rs * ga.z, hi_f(ykeep[2 * i4 + 1]) * rs * ga.w);
        *(uint2*)(dst + d) = o;
        o.x = pack2(lo_f(ykeep[8 + 2 * i4]) * rs * gb.x, hi_f(ykeep[8 + 2 * i4]) * rs * gb.y);
        o.y = pack2(lo_f(ykeep[8 + 2 * i4 + 1]) * rs * gb.z, hi_f(ykeep[8 + 2 * i4 + 1]) * rs * gb.w);
        *(uint2*)(dst + 32 + d) = o;
      }
    }
    {
      const int q2 = tid & 31, cg8 = tid >> 5;
      float tot = 0.f;
#pragma unroll
      for (int hh = 0; hh < 8; ++hh) tot += ssq[q2 * 8 + hh];
      const float rs = rsqrtf(tot * (1.f / 512.f) + EPS_C);
      bf16_t* dst = P.CAT + (size_t)(b * SEQ + t0 + q2) * 1024 + 512 + 256;
#pragma unroll
      for (int c8 = 0; c8 < 4; ++c8) {
        const int cl = cg8 * 32 + c8 * 8;
        float o1[8];
#pragma unroll
        for (int k = 0; k < 8; ++k) o1[k] = yacc[(cl + k) * 32 + q2] * rs * gn[256 + cl + k];
        *(bf16x8*)(dst + cl) = pack8(o1);
      }
    }
  }
  __syncthreads();
}

DEV void ln_row(const float* g, const float* bta, bf16_t* xb, int lane, const float (&pre)[16]) {
  float s = 0.f;
#pragma unroll
  for (int k = 0; k < 16; ++k) s += pre[k];
  const float mean = wave_sum(s) * (1.f / 1024.f);
  float v = 0.f;
#pragma unroll
  for (int k = 0; k < 16; ++k) { const float d = pre[k] - mean; v += d * d; }
  const float rstd = rsqrtf(wave_sum(v) * (1.f / 1024.f) + EPS_C);
#pragma unroll
  for (int hsel = 0; hsel < 2; ++hsel) {
    const int c0 = hsel * 512 + lane * 8;
    const float4 ga = *(const float4*)(g + c0), gb = *(const float4*)(g + c0 + 4);
    const float4 ba = *(const float4*)(bta + c0), bb = *(const float4*)(bta + c0 + 4);
    float o[8];
    o[0] = (pre[hsel * 8 + 0] - mean) * rstd * ga.x + ba.x; o[1] = (pre[hsel * 8 + 1] - mean) * rstd * ga.y + ba.y;
    o[2] = (pre[hsel * 8 + 2] - mean) * rstd * ga.z + ba.z; o[3] = (pre[hsel * 8 + 3] - mean) * rstd * ga.w + ba.w;
    o[4] = (pre[hsel * 8 + 4] - mean) * rstd * gb.x + bb.x; o[5] = (pre[hsel * 8 + 5] - mean) * rstd * gb.y + bb.y;
    o[6] = (pre[hsel * 8 + 6] - mean) * rstd * gb.z + bb.z; o[7] = (pre[hsel * 8 + 7] - mean) * rstd * gb.w + bb.w;
    *(bf16x8*)(xb + c0) = pack8(o);
  }
}
__device__ void ln1_phase(const Params& P, int l) {
  const int lane = opaque_tid() & 63, w = opaque_tid() >> 6;
  for (int r4 = blockIdx.x; r4 < T_TOK / 4; r4 += gridDim.x) {
    const int t = r4 * 4 + w;
    const bf16_t* mx = P.MIX + (size_t)t * 1024;
    bf16_t* xb = P.XB + (size_t)t * 1024;
    float pre[16];
#pragma unroll
    for (int hsel = 0; hsel < 2; ++hsel) {
      float r[8];
      if (l == 0) {
        const float* xr = P.x + (size_t)t * 1024 + hsel * 512 + lane * 8;
        const float4 a = *(const float4*)xr, b = *(const float4*)(xr + 4);
        r[0] = a.x; r[1] = a.y; r[2] = a.z; r[3] = a.w; r[4] = b.x; r[5] = b.y; r[6] = b.z; r[7] = b.w;
      } else {
        const uint4 xx = *(const uint4*)(xb + hsel * 512 + lane * 8);
        r[0] = lo_f(xx.x); r[1] = hi_f(xx.x); r[2] = lo_f(xx.y); r[3] = hi_f(xx.y); r[4] = lo_f(xx.z); r[5] = hi_f(xx.z); r[6] = lo_f(xx.w); r[7] = hi_f(xx.w);
      }
      const uint4 mm = *(const uint4*)(mx + hsel * 512 + lane * 8);
      pre[hsel * 8 + 0] = ALPHA_C * r[0] + lo_f(mm.x); pre[hsel * 8 + 1] = ALPHA_C * r[1] + hi_f(mm.x);
      pre[hsel * 8 + 2] = ALPHA_C * r[2] + lo_f(mm.y); pre[hsel * 8 + 3] = ALPHA_C * r[3] + hi_f(mm.y);
      pre[hsel * 8 + 4] = ALPHA_C * r[4] + lo_f(mm.z); pre[hsel * 8 + 5] = ALPHA_C * r[5] + hi_f(mm.z);
      pre[hsel * 8 + 6] = ALPHA_C * r[6] + lo_f(mm.w); pre[hsel * 8 + 7] = ALPHA_C * r[7] + hi_f(mm.w);
    }
    ln_row(P.ln1_g + l * 1024, P.ln1_b + l * 1024, xb, lane, pre);
  }
}

DEV unsigned fkey(float v) { const unsigned u = __float_as_uint(v); return (u & 0x80000000u) ? ~u : (u | 0x80000000u); }
DEV float keyf(unsigned k) { const unsigned u = (k & 0x80000000u) ? (k ^ 0x80000000u) : ~k; return __uint_as_float(u); }
#define TK_INS(L, val) { unsigned _v = (val); _Pragma("unroll") for (int _i = 0; _i < 16; ++_i) { const unsigned _hi = max(L[_i], _v); _v = min(L[_i], _v); L[_i] = _hi; } }

#define TK_CE(a, b) { const unsigned _h = max(a, b), _l = min(a, b); a = _h; b = _l; }
DEV void sort16_desc(unsigned (&x)[16]) {
#pragma unroll
  for (int k = 2; k <= 16; k <<= 1)
#pragma unroll
    for (int j = k >> 1; j > 0; j >>= 1)
#pragma unroll
      for (int i = 0; i < 16; ++i) {
        const int p = i ^ j;
        if (p > i) {
          if ((i & k) == 0) { TK_CE(x[i], x[p]); } else { TK_CE(x[p], x[i]); }
        }
      }
}
DEV void merge_top16(unsigned (&x)[16], const unsigned (&y)[16]) {
#pragma unroll
  for (int i = 0; i < 16; ++i) x[i] = max(x[i], y[15 - i]);
#pragma unroll
  for (int j = 8; j > 0; j >>= 1)
#pragma unroll
    for (int i = 0; i < 16; ++i) {
      const int p = i ^ j;
      if (p > i) { TK_CE(x[i], x[p]); }
    }
}
__device__ void peer_topk_item(const Params& P, int l, int bitem, char* smem) {
  const int tid = opaque_tid(), lane = tid & 63, w = tid >> 6;
  const int q = lane & 31, hk = lane >> 5;
  unsigned char* idxs = (unsigned char*)smem + w * 1024;
  const int wi = bitem * 4 + w;
  const int tile = wi >> 3, h = wi & 7;
  const int t = tile * 32 + q;
  unsigned L0[16], L1[16];
#pragma unroll
  for (int i = 0; i < 16; ++i) { L0[i] = 0u; L1[i] = 0u; }
#pragma unroll 1
  for (int c = 0; c < 2; ++c) {
    unsigned Lc[16];
#pragma unroll
    for (int i = 0; i < 16; ++i) Lc[i] = 0u;
    f32x16 acc[4];
#pragma unroll
    for (int mt = 0; mt < 4; ++mt)
#pragma unroll
      for (int i = 0; i < 16; ++i) acc[mt][i] = 0.f;
    const bf16_t* qrow = P.QP + (size_t)t * 2048 + h * 256 + c * 128 + hk * 8;
    const bf16_t* sk = P.SK + (size_t)((l * 2 + c) * 128) * 128 + (size_t)q * 128 + hk * 8;
#pragma unroll
    for (int ks = 0; ks < 8; ++ks) {
      const bf16x8 bq = *(const bf16x8*)(qrow + ks * 16);
#pragma unroll
      for (int mt = 0; mt < 4; ++mt) {
        const bf16x8 a = *(const bf16x8*)(sk + (size_t)(mt * 32) * 128 + ks * 16);
        acc[mt] = mfma32(a, bq, acc[mt]);
      }
    }
    {
      unsigned G1[16], G2[16], G3[16];
#pragma unroll
      for (int i = 0; i < 16; ++i) {
        const int kb0 = (i & 3) + 8 * (i >> 2) + 4 * hk;
        Lc[i] = (fkey(acc[0][i]) & ~0x7Fu) | (unsigned)(127 - kb0);
        G1[i] = (fkey(acc[1][i]) & ~0x7Fu) | (unsigned)(127 - (32 + kb0));
        G2[i] = (fkey(acc[2][i]) & ~0x7Fu) | (unsigned)(127 - (64 + kb0));
        G3[i] = (fkey(acc[3][i]) & ~0x7Fu) | (unsigned)(127 - (96 + kb0));
      }
      sort16_desc(Lc); sort16_desc(G1); sort16_desc(G2); sort16_desc(G3);
      merge_top16(Lc, G1); merge_top16(G2, G3); merge_top16(Lc, G2);
    }
    {
      unsigned oth[16];
#pragma unroll
      for (int i = 0; i < 16; ++i) oth[i] = xor32_u(Lc[i]);
      merge_top16(Lc, oth);
    }
    if (hk == 0) {
#pragma unroll
      for (int i = 0; i < 16; ++i) idxs[q * 32 + c * 16 + i] = (unsigned char)(127u - (Lc[i] & 0x7Fu));
    }
#pragma unroll
    for (int i = 0; i < 16; ++i) { L0[i] = L1[i]; L1[i] = Lc[i]; }
  }
  unsigned C[16];
#pragma unroll
  for (int i = 0; i < 16; ++i) C[i] = 0u;
#pragma unroll
  for (int i = 0; i < 16; ++i) {
    const float v0 = keyf(L0[i] & ~0x7Fu);
#pragma unroll
    for (int j = 0; j < 16; ++j) {
      if ((i + 1) * (j + 1) <= 16) {
        const float v = v0 + keyf(L1[j] & ~0x7Fu);
        const unsigned key = (fkey(v) & ~0xFFu) | (unsigned)(255 - (i * 16 + j));
        TK_INS(C, key);
      }
    }
  }
  float cv[16]; float den = 0.f;
  const float cmax = keyf(C[0] & ~0xFFu);
#pragma unroll
  for (int k = 0; k < 16; ++k) { cv[k] = __expf(keyf(C[k] & ~0xFFu) - cmax); den += cv[k]; }
  const float rden = 1.f / den;
  __syncthreads();
#pragma unroll
  for (int k = 0; k < 8; ++k) {
    const unsigned hmsk = (unsigned)(-hk);
    const unsigned ck = (C[k] & ~hmsk) | (C[k + 8] & hmsk);
    const float gk = __uint_as_float((__float_as_uint(cv[k]) & ~hmsk) | (__float_as_uint(cv[k + 8]) & hmsk)) * rden;
    const int flat = 255 - (int)(ck & 0xFFu);
    const int ea = idxs[q * 32 + (flat >> 4)], eb = idxs[q * 32 + 16 + (flat & 15)];
    const size_t o = (size_t)t * 128 + h * 16 + hk * 8 + k;
    P.EXP[o] = ea * 128 + eb;
    P.GATE[o] = gk;
  }
  __syncthreads();
}


__device__ void peer_q_topk_item(const Params& P, int l, int item, char* smem) {
  bf16_t* As = (bf16_t*)smem;
  bf16_t* Bs = As + 128 * 72;
  bf16_t* Qs = (bf16_t*)(smem + 36864);
  unsigned char* idxs = (unsigned char*)smem;
  const int tid = opaque_tid(), lane = tid & 63, w = tid >> 6;
  const int wm = w >> 1, wn = w & 1, lr = lane & 31, hk = lane >> 5;
  const int q = lr;
  const int mt = item >> 3, h = item & 7;
  const int m0 = mt * 128;
  const int t = m0 + w * 32 + q;
  unsigned L0[16], L1[16];
#pragma unroll
  for (int i = 0; i < 16; ++i) { L0[i] = 0u; L1[i] = 0u; }
#pragma unroll 1
  for (int c = 0; c < 2; ++c) {
    {
      f32x16 acc[2][2];
      gemm_core(P.XB, P.WqT + (size_t)l * 2048 * 1024, m0, (h * 2 + c) * 128, As, Bs, tid, acc);
#pragma unroll
      for (int mi = 0; mi < 2; ++mi)
#pragma unroll
        for (int ni = 0; ni < 2; ++ni) {
          const int col = wn * 64 + ni * 32 + lr;
          const int rbase = wm * 64 + mi * 32 + 4 * hk;
#pragma unroll
          for (int i = 0; i < 16; ++i) Qs[(rbase + (i & 3) + 8 * (i >> 2)) * 136 + col] = f2bf(acc[mi][ni][i]);
        }
    }
    __syncthreads();
    {
      const bf16_t* skg = P.SK + (size_t)((l * 2 + c) * 128) * 128;
#pragma unroll
      for (int k = 0; k < 8; ++k) {
        const int ch = tid + 256 * k;
        const int row = ch >> 4, c8 = (ch & 15) * 8;
        *(uint4*)(As + row * 136 + c8) = *(const uint4*)(skg + row * 128 + c8);
      }
    }
    __syncthreads();
    unsigned Lc[16];
    {
      f32x16 sa[4];
#pragma unroll
      for (int m4 = 0; m4 < 4; ++m4)
#pragma unroll
        for (int i = 0; i < 16; ++i) sa[m4][i] = 0.f;
      const bf16_t* qrow = Qs + (w * 32 + q) * 136 + hk * 8;
      const bf16_t* sk = As + q * 136 + hk * 8;
#pragma unroll
      for (int ks = 0; ks < 8; ++ks) {
        const bf16x8 bq = *(const bf16x8*)(qrow + ks * 16);
#pragma unroll
        for (int m4 = 0; m4 < 4; ++m4) {
          const bf16x8 a = *(const bf16x8*)(sk + (m4 * 32) * 136 + ks * 16);
          sa[m4] = mfma32(a, bq, sa[m4]);
        }
      }
      unsigned G1[16], G2[16], G3[16];
#pragma unroll
      for (int i = 0; i < 16; ++i) {
        const int kb0 = (i & 3) + 8 * (i >> 2) + 4 * hk;
        Lc[i] = (fkey(sa[0][i]) & ~0x7Fu) | (unsigned)(127 - kb0);
        G1[i] = (fkey(sa[1][i]) & ~0x7Fu) | (unsigned)(127 - (32 + kb0));
        G2[i] = (fkey(sa[2][i]) & ~0x7Fu) | (unsigned)(127 - (64 + kb0));
        G3[i] = (fkey(sa[3][i]) & ~0x7Fu) | (unsigned)(127 - (96 + kb0));
      }
      sort16_desc(Lc); sort16_desc(G1); sort16_desc(G2); sort16_desc(G3);
      merge_top16(Lc, G1); merge_top16(G2, G3); merge_top16(Lc, G2);
    }
    {
      unsigned oth[16];
#pragma unroll
      for (int i = 0; i < 16; ++i) oth[i] = xor32_u(Lc[i]);
      merge_top16(Lc, oth);
    }
#pragma unroll
    for (int i = 0; i < 16; ++i) { L0[i] = L1[i]; L1[i] = Lc[i]; }
  }
  unsigned C[16], GB[16], GC[16];
  float v0s[16], v1s[16];
#pragma unroll
  for (int i = 0; i < 16; ++i) { v0s[i] = keyf(L0[i] & ~0x7Fu); v1s[i] = keyf(L1[i] & ~0x7Fu); }
#define CKEY(i, j) ((fkey(v0s[i] + v1s[j]) & ~0xFFu) | (unsigned)(255 - ((i) * 16 + (j))))
#pragma unroll
  for (int j = 0; j < 16; ++j) C[j] = CKEY(0, j);
#pragma unroll
  for (int j = 0; j < 8; ++j) GB[j] = CKEY(1, j);
#pragma unroll
  for (int j = 0; j < 5; ++j) GB[8 + j] = CKEY(2, j);
#pragma unroll
  for (int j = 0; j < 3; ++j) GB[13 + j] = CKEY(4, j);
#pragma unroll
  for (int j = 0; j < 4; ++j) GC[j] = CKEY(3, j);
  GC[4] = CKEY(5, 0); GC[5] = CKEY(5, 1); GC[6] = CKEY(6, 0); GC[7] = CKEY(6, 1); GC[8] = CKEY(7, 0); GC[9] = CKEY(7, 1);
  GC[10] = CKEY(8, 0); GC[11] = CKEY(9, 0); GC[12] = CKEY(10, 0); GC[13] = CKEY(11, 0); GC[14] = CKEY(12, 0); GC[15] = CKEY(13, 0);
  sort16_desc(GB); sort16_desc(GC);
  merge_top16(C, GB); merge_top16(C, GC);
  { const unsigned k14 = CKEY(14, 0), k15 = CKEY(15, 0); TK_INS(C, k14); TK_INS(C, k15); }
#undef CKEY
  float cv[16]; float den = 0.f;
  const float cmax = keyf(C[0] & ~0xFFu);
#pragma unroll
  for (int k = 0; k < 16; ++k) { cv[k] = __expf(keyf(C[k] & ~0xFFu) - cmax); den += cv[k]; }
  const float rden = 1.f / den;
  __syncthreads();
  if (hk == 0) {
#pragma unroll
    for (int i = 0; i < 16; ++i) {
      idxs[w * 1024 + q * 32 + i] = (unsigned char)(127u - (L0[i] & 0x7Fu));
      idxs[w * 1024 + q * 32 + 16 + i] = (unsigned char)(127u - (L1[i] & 0x7Fu));
    }
  }
  __syncthreads();
  {
    int eo[8]; float go[8];
    const unsigned hmsk = (unsigned)(-hk);
#pragma unroll
    for (int k = 0; k < 8; ++k) {
      const unsigned ck = (C[k] & ~hmsk) | (C[k + 8] & hmsk);
      go[k] = __uint_as_float((__float_as_uint(cv[k]) & ~hmsk) | (__float_as_uint(cv[k + 8]) & hmsk)) * rden;
      const int flat = 255 - (int)(ck & 0xFFu);
      const int ea = idxs[w * 1024 + q * 32 + (flat >> 4)], eb = idxs[w * 1024 + q * 32 + 16 + (flat & 15)];
      eo[k] = ea * 128 + eb;
    }
    const size_t o = (size_t)t * 128 + h * 16 + hk * 8;
    int4 e0, e1; e0.x = eo[0]; e0.y = eo[1]; e0.z = eo[2]; e0.w = eo[3]; e1.x = eo[4]; e1.y = eo[5]; e1.z = eo[6]; e1.w = eo[7];
    float4 g0, g1; g0.x = go[0]; g0.y = go[1]; g0.z = go[2]; g0.w = go[3]; g1.x = go[4]; g1.y = go[5]; g1.z = go[6]; g1.w = go[7];
    *(int4*)(P.EXP + o) = e0; *(int4*)(P.EXP + o + 4) = e1;
    *(float4*)(P.GATE + o) = g0; *(float4*)(P.GATE + o + 4) = g1;
  }
  __syncthreads();
}

DEV f32x2 cvt8(unsigned w, bool hi) { return hi ? __builtin_amdgcn_cvt_pk_f32_fp8((int)w, true) : __builtin_amdgcn_cvt_pk_f32_fp8((int)w, false); }
__device__ void peer_gather_phase(const Params& P, int l, bool do_store) {
  const int lane = opaque_tid() & 63, w = opaque_tid() >> 6;
  const unsigned char* U = P.U8 + (size_t)l * 16384 * 768 + (lane & 31) * 24;
  const unsigned char* V = P.V8 + (size_t)l * 16384 * 512 + lane * 8;
  const float* SU = P.SU + l * 16384;
  const float* SV = P.SV + l * 16384;
  int nev0, nev1; float ngv0, ngv1; uint4 nxa, nxc;
  {
    const int t = blockIdx.x * 4 + w;
    nev0 = P.EXP[(size_t)t * 128 + lane]; nev1 = P.EXP[(size_t)t * 128 + 64 + lane];
    ngv0 = P.GATE[(size_t)t * 128 + lane]; ngv1 = P.GATE[(size_t)t * 128 + 64 + lane];
    const bf16_t* xb = P.XB + (size_t)t * 1024 + lane * 16;
    nxa = *(const uint4*)xb; nxc = *(const uint4*)(xb + 8);
  }
  for (int r4 = blockIdx.x; r4 < T_TOK / 4; r4 += gridDim.x) {
    const int t = r4 * 4 + w;
    f32x2 xf[8];
    const int ev0 = nev0, ev1 = nev1; const float gv0 = ngv0, gv1 = ngv1;
    {
      const uint4 xa = nxa, xc = nxc;
      xf[0] = f32x2{lo_f(xa.x), hi_f(xa.x)}; xf[1] = f32x2{lo_f(xa.y), hi_f(xa.y)}; xf[2] = f32x2{lo_f(xa.z), hi_f(xa.z)}; xf[3] = f32x2{lo_f(xa.w), hi_f(xa.w)};
      xf[4] = f32x2{lo_f(xc.x), hi_f(xc.x)}; xf[5] = f32x2{lo_f(xc.y), hi_f(xc.y)}; xf[6] = f32x2{lo_f(xc.z), hi_f(xc.z)}; xf[7] = f32x2{lo_f(xc.w), hi_f(xc.w)};
    }
    f32x2 xu[16];
    {
      const bf16_t* xq = P.XB + (size_t)t * 1024 + (lane & 31) * 32;
      const uint4 q0 = *(const uint4*)xq, q1 = *(const uint4*)(xq + 8), q2 = *(const uint4*)(xq + 16), q3 = *(const uint4*)(xq + 24);
      xu[0] = f32x2{lo_f(q0.x), hi_f(q0.x)}; xu[1] = f32x2{lo_f(q0.y), hi_f(q0.y)}; xu[2] = f32x2{lo_f(q0.z), hi_f(q0.z)}; xu[3] = f32x2{lo_f(q0.w), hi_f(q0.w)};
      xu[4] = f32x2{lo_f(q1.x), hi_f(q1.x)}; xu[5] = f32x2{lo_f(q1.y), hi_f(q1.y)}; xu[6] = f32x2{lo_f(q1.z), hi_f(q1.z)}; xu[7] = f32x2{lo_f(q1.w), hi_f(q1.w)};
      xu[8] = f32x2{lo_f(q2.x), hi_f(q2.x)}; xu[9] = f32x2{lo_f(q2.y), hi_f(q2.y)}; xu[10] = f32x2{lo_f(q2.z), hi_f(q2.z)}; xu[11] = f32x2{lo_f(q2.w), hi_f(q2.w)};
      xu[12] = f32x2{lo_f(q3.x), hi_f(q3.x)}; xu[13] = f32x2{lo_f(q3.y), hi_f(q3.y)}; xu[14] = f32x2{lo_f(q3.z), hi_f(q3.z)}; xu[15] = f32x2{lo_f(q3.w), hi_f(q3.w)};
    }
    f32x2 y[8];
#pragma unroll
    for (int k = 0; k < 8; ++k) y[k] = f32x2{0.f, 0.f};
    {
      const int r4n = (r4 + (int)gridDim.x < T_TOK / 4) ? r4 + (int)gridDim.x : r4;
      const int tn = r4n * 4 + w;
      nev0 = P.EXP[(size_t)tn * 128 + lane]; nev1 = P.EXP[(size_t)tn * 128 + 64 + lane];
      ngv0 = P.GATE[(size_t)tn * 128 + lane]; ngv1 = P.GATE[(size_t)tn * 128 + 64 + lane];
      const bf16_t* xbn = P.XB + (size_t)tn * 1024 + lane * 16;
      nxa = *(const uint4*)xbn; nxc = *(const uint4*)(xbn + 8);
    }
    const float sux0 = SU[ev0], sux1 = SU[ev1];
    const float gsx0 = gv0 * SV[ev0], gsx1 = gv1 * SV[ev1];
    const bool uphi = (lane >= 32);
    uint2 uA[12], uB[12]; uint2 vA[8], vB[8];
    auto load_batch = [&](uint2 (&u6)[12], uint2 (&v8)[8], int bt) {
      const int evs = (bt < 8) ? ev0 : ev1;
      const int kb = (bt & 7) * 8;
#pragma unroll
      for (int pr = 0; pr < 4; ++pr) {
        const int ea = __builtin_amdgcn_readlane(evs, kb + 2 * pr), eb = __builtin_amdgcn_readlane(evs, kb + 2 * pr + 1);
        const uint2* up = (const uint2*)(U + (size_t)(uphi ? eb : ea) * 768);
        u6[3 * pr] = up[0]; u6[3 * pr + 1] = up[1]; u6[3 * pr + 2] = up[2];
        v8[2 * pr] = *(const uint2*)(V + (size_t)ea * 512);
        v8[2 * pr + 1] = *(const uint2*)(V + (size_t)eb * 512);
      }
    };
    auto compute_batch = [&](const uint2 (&u6)[12], const uint2 (&v8)[8], int bt) {
      const int kb = (bt & 7) * 8;
      float dvec = 0.f;
#pragma unroll
      for (int pr = 0; pr < 4; ++pr) {
        v6u_t qv; qv[0] = u6[3 * pr].x; qv[1] = u6[3 * pr].y; qv[2] = u6[3 * pr + 1].x; qv[3] = u6[3 * pr + 1].y; qv[4] = u6[3 * pr + 2].x; qv[5] = u6[3 * pr + 2].y;
        const v32f_t wv = __builtin_amdgcn_cvt_scalef32_pk32_f32_fp6(qv, 1.0f);
        f32x2 a2 = f32x2{0.f, 0.f};
#pragma unroll
        for (int i = 0; i < 16; ++i) a2 += f32x2{wv[2 * i], wv[2 * i + 1]} * xu[i];
        float hs = a2.x + a2.y;
        hs += dpp_row_shr(hs, 1); hs += dpp_row_shr(hs, 2); hs += dpp_row_shr(hs, 4); hs += dpp_row_shr(hs, 8);
        hs += __builtin_bit_cast(float, __builtin_amdgcn_update_dpp(0, __builtin_bit_cast(int, hs), 0x142, 0xa, 0xf, false));
        const float da = __builtin_bit_cast(float, __builtin_amdgcn_readlane(__builtin_bit_cast(int, hs), 31));
        const float db = __builtin_bit_cast(float, __builtin_amdgcn_readlane(__builtin_bit_cast(int, hs), 63));
        dvec = (lane == kb + 2 * pr) ? da : dvec;
        dvec = (lane == kb + 2 * pr + 1) ? db : dvec;
      }
      const float sux = (bt < 8) ? sux0 : sux1;
      const float gsx = (bt < 8) ? gsx0 : gsx1;
      const float avec = gelu_t(dvec * sux) * gsx;
#pragma unroll
      for (int j = 0; j < 8; ++j) {
        const float a = __builtin_bit_cast(float, __builtin_amdgcn_readlane(__builtin_bit_cast(int, avec), kb + j));
        const f32x2 aa = f32x2{a, a};
        y[0] += aa * __builtin_amdgcn_cvt_scalef32_pk_f32_fp4(v8[j].x, 1.0f, 0); y[1] += aa * __builtin_amdgcn_cvt_scalef32_pk_f32_fp4(v8[j].x, 1.0f, 1);
        y[2] += aa * __builtin_amdgcn_cvt_scalef32_pk_f32_fp4(v8[j].x, 1.0f, 2); y[3] += aa * __builtin_amdgcn_cvt_scalef32_pk_f32_fp4(v8[j].x, 1.0f, 3);
        y[4] += aa * __builtin_amdgcn_cvt_scalef32_pk_f32_fp4(v8[j].y, 1.0f, 0); y[5] += aa * __builtin_amdgcn_cvt_scalef32_pk_f32_fp4(v8[j].y, 1.0f, 1);
        y[6] += aa * __builtin_amdgcn_cvt_scalef32_pk_f32_fp4(v8[j].y, 1.0f, 2); y[7] += aa * __builtin_amdgcn_cvt_scalef32_pk_f32_fp4(v8[j].y, 1.0f, 3);
      }
    };
    load_batch(uA, vA, 0);
#pragma unroll 1
    for (int bt = 0; bt < 16; bt += 2) {
      load_batch(uB, vB, bt + 1);
      compute_batch(uA, vA, bt);
      load_batch(uA, vA, (bt + 2 < 16) ? bt + 2 : 15);
      compute_batch(uB, vB, bt + 1);
    }
    float* xfp = P.out + (size_t)t * 1024 + lane * 16;
    float pre[16];
#pragma unroll
    for (int k2 = 0; k2 < 8; ++k2) {
      pre[2 * k2 + 0] = ALPHA_C * xf[k2].x + y[k2].x;
      pre[2 * k2 + 1] = ALPHA_C * xf[k2].y + y[k2].y;
    }
    float sm = 0.f;
#pragma unroll
    for (int k = 0; k < 16; ++k) sm += pre[k];
    const float mean = wave_sum(sm) * (1.f / 1024.f);
    float vs = 0.f;
#pragma unroll
    for (int k = 0; k < 16; ++k) { const float dd = pre[k] - mean; vs += dd * dd; }
    const float rstd = rsqrtf(wave_sum(vs) * (1.f / 1024.f) + EPS_C);
    const float* g2 = P.ln2_g + l * 1024 + lane * 16;
    const float* b2 = P.ln2_b + l * 1024 + lane * 16;
    float o[16];
#pragma unroll
    for (int k4 = 0; k4 < 4; ++k4) {
      const float4 gg = *(const float4*)(g2 + 4 * k4), bb = *(const float4*)(b2 + 4 * k4);
      o[4 * k4 + 0] = (pre[4 * k4 + 0] - mean) * rstd * gg.x + bb.x; o[4 * k4 + 1] = (pre[4 * k4 + 1] - mean) * rstd * gg.y + bb.y;
      o[4 * k4 + 2] = (pre[4 * k4 + 2] - mean) * rstd * gg.z + bb.z; o[4 * k4 + 3] = (pre[4 * k4 + 3] - mean) * rstd * gg.w + bb.w;
      float4 ov; ov.x = o[4 * k4]; ov.y = o[4 * k4 + 1]; ov.z = o[4 * k4 + 2]; ov.w = o[4 * k4 + 3];
      if (do_store && l == 1) *(float4*)(xfp + 4 * k4) = ov;
    }
    bf16_t* xbo = P.XB + (size_t)t * 1024 + lane * 16;
    if (do_store && l == 0) {
      *(bf16x8*)(xbo) = pack8(o);
      *(bf16x8*)(xbo + 8) = pack8(o + 8);
    } else if (o[0] == 123456.789f) {
      *(bf16x8*)(xbo) = pack8(o);
    }
  }
}

#define XB_TMO      128
#define XB_XCNT(j)  (256  + 64 * (j))
#define XB_XSUB(j)  (1280 + 64 * (j))
#define XB_XGEN(j)  (2304 + 64 * (j))
#define XB_TOP      3328
#define XB_TOPGEN   3392
#define XCD_BAR_WORDS 3456
#define XB_SPIN_CAP (1u << 22)
#define LAS __attribute__((address_space(3)))
DEV unsigned xb_ld(unsigned* p)              { return __hip_atomic_load(p, __ATOMIC_RELAXED, __HIP_MEMORY_SCOPE_AGENT); }
DEV unsigned xb_add(unsigned* p, unsigned v) { return __hip_atomic_fetch_add(p, v, __ATOMIC_RELAXED, __HIP_MEMORY_SCOPE_AGENT); }
DEV unsigned xb_xcc_id() { return (unsigned)__builtin_amdgcn_s_getreg((3 << 11) | 20) & 0xFu; }
#define XB_SPIN(cond, bar) do { unsigned _sp = 0; while (cond) { __builtin_amdgcn_s_sleep(1); \
    if ((++_sp & 255u) == 0u) { if (xb_ld(&(bar)[XB_TMO])) break; if (_sp > XB_SPIN_CAP) { atomicAdd(&(bar)[XB_TMO], 1u); break; } } } } while (0)
struct XcdBarrier { unsigned* bar; unsigned x; volatile LAS unsigned* st; };
DEV XcdBarrier xcd_barrier_post(unsigned* bar, volatile LAS unsigned* st) {
  XcdBarrier b; b.bar = bar; b.x = xb_xcc_id(); b.st = st;
  if (threadIdx.x == 0) (void)xb_add(&bar[XB_XCNT(b.x)], 1u);
  return b;
}
DEV void xcd_barrier_complete(unsigned* bar, unsigned x, unsigned& nloc, unsigned& nx) {
  const unsigned G = gridDim.x * gridDim.y * gridDim.z;
  unsigned sum, cnt, mine, sp = 0u;
  for (;;) {
    sum = 0u; cnt = 0u; mine = 0u;
#pragma unroll
    for (unsigned j = 0; j < 16; ++j) { const unsigned c = xb_ld(&bar[XB_XCNT(j)]); sum += c; cnt += (c > 0u) ? 1u : 0u; mine = (j == x) ? c : mine; }
    if (sum == G) break;
    __builtin_amdgcn_s_sleep(1);
    if ((++sp & 255u) == 0u) { if (xb_ld(&bar[XB_TMO])) break; if (sp > XB_SPIN_CAP) { atomicAdd(&bar[XB_TMO], 1u); break; } }
  }
  nloc = mine > 0u ? mine : 1u; nx = cnt > 0u ? cnt : 1u;
}
DEV void xcd_barrier(const XcdBarrier& b) {
  asm volatile("s_waitcnt vmcnt(0)" ::: "memory");
  __syncthreads();
  if (threadIdx.x == 0) {
    unsigned* bar = b.bar;
    __builtin_amdgcn_s_waitcnt(0);
    unsigned nloc = b.st[0], nx = b.st[1];
    if (nloc == 0u) { xcd_barrier_complete(bar, b.x, nloc, nx); b.st[0] = nloc; b.st[1] = nx; }
    const unsigned old = xb_add(&bar[XB_XSUB(b.x)], 1u);
    const unsigned gen = old / nloc;
    if (old + 1u == (gen + 1u) * nloc) {
      __builtin_amdgcn_fence(__ATOMIC_RELEASE, "agent");
      asm volatile("s_waitcnt vmcnt(0)" ::: "memory");
      const unsigned og = xb_add(&bar[XB_TOP], 1u);
      const unsigned tg = og / nx;
      if (og + 1u == (tg + 1u) * nx) xb_add(&bar[XB_TOPGEN], 1u);
      else XB_SPIN(xb_ld(&bar[XB_TOPGEN]) == tg, bar);
      __builtin_amdgcn_fence(__ATOMIC_ACQUIRE, "agent");
      xb_add(&bar[XB_XGEN(b.x)], 1u);
      asm volatile("s_waitcnt vmcnt(0)" ::: "memory");
    } else {
      XB_SPIN(xb_ld(&bar[XB_XGEN(b.x)]) == gen, bar);
      __builtin_amdgcn_fence(__ATOMIC_ACQUIRE, "agent");
      asm volatile("s_waitcnt vmcnt(0)" ::: "memory");
    }
  }
  __syncthreads();
}

__device__ void run_phase(const Params& P, int ph, char* smem, bool do_store) {
  if (ph == 0) { phase_prologue(P); return; }
  const int l = (ph - 1) >> 3, sub = (ph - 1) & 7;
  const int G = gridDim.x, bid = blockIdx.x;
  switch (sub) {
    case 0: {
      const bool quant_first = ((bid >> 8) & 1) == 0;
      if (l == 0 && quant_first) { quant_rows_fp6(P.peer_u, P.U8, P.SU, 2 * 16384); quant_rows_fp4(P.peer_v, P.V8, P.SV, 2 * 16384); }
      gemm_phase256<0>(P, l, P.XB, P.WinT + (size_t)l * NINP * 1024, 19, smem);
      if (l == 0 && !quant_first) { quant_rows_fp6(P.peer_u, P.U8, P.SU, 2 * 16384); quant_rows_fp4(P.peer_v, P.V8, P.SV, 2 * 16384); }
    } break;
    case 1: {
      for (int it = bid; it < 512 + 1024; it += G) {
        if (it < 512) compress_block_item(P, l, it, smem);
        else lru_local_item(P, l, it - 512, smem);
        __syncthreads();
      }
    } break;
    case 2: {
      {
        unsigned* qh = P.bar + XCD_BAR_WORDS + l * 8 * 64;
        unsigned* slot = (unsigned*)(smem + 73712);
        for (int qi = 0; qi < 8; ++qi) {
          const int qsel = (bid + qi) & 7;
          for (;;) {
            __syncthreads();
            if (opaque_tid() == 0) *slot = __hip_atomic_fetch_add(&qh[qsel * 64], 1u, __ATOMIC_RELAXED, __HIP_MEMORY_SCOPE_AGENT);
            __syncthreads();
            const unsigned k = *slot;
            if (k >= 128u) break;
            nsa_item(P, l, (int)((127u - k) << 3) | qsel, smem);
          }
        }
        for (;;) {
          __syncthreads();
          if (opaque_tid() == 0) *slot = __hip_atomic_fetch_add(&qh[32], 1u, __ATOMIC_RELAXED, __HIP_MEMORY_SCOPE_AGENT);
          __syncthreads();
          const unsigned k = *slot;
          if (k >= 512u) break;
          lru_final_item(P, l, (int)k);
        }
      }
    } break;
    case 3: gemm_phase256<1>(P, l, P.CAT, P.WoutT + (size_t)l * 1024 * 1024, 8, smem); break;
    case 4: ln1_phase(P, l); break;
    case 5: {
      const int xcd = bid & 7, lb = bid >> 3, nbx = (G - xcd + 7) >> 3;
      for (int lt = lb; lt < 256; lt += nbx) peer_q_topk_item(P, l, xcd * 256 + lt, smem);
    } break;
    case 6: break;
    case 7: peer_gather_phase(P, l, do_store); break;
  }
}

__global__ void __launch_bounds__(256, 2) mega_kernel(Params P, int ph_lo, int ph_hi) {
  __shared__ __attribute__((aligned(16))) char smem[73728];
  __shared__ uint4 xb_words;
  if (threadIdx.x == 0) xb_words = make_uint4(0u, 0u, 0u, 0u);
  __syncthreads();
  XcdBarrier xb = xcd_barrier_post(P.bar, (volatile LAS unsigned*)&xb_words);
  for (int ph = ph_lo; ph < ph_hi; ++ph) {
    const int nrep = (ph == PROBE_DUP) ? 2 : 1;
#pragma unroll 1
    for (int rep = 0; rep < nrep; ++rep) { run_phase(P, ph, smem, rep + 1 == nrep); __syncthreads(); }
    if (ph + 1 < ph_hi) {
      if (ph_hi > 1000) cg::this_grid().sync();
      if (ph == 0 || ((ph - 1) & 7) != 6) xcd_barrier(xb);
    }
  }
}

extern "C" void kernel_launch(void* const* d_in, const int* in_sizes, int n_in, void* d_out, int out_size, void* d_ws, size_t ws_size,
                              hipStream_t stream) {
  Params P{};
  const float* const* in = (const float* const*)d_in;
  P.x = in[0]; P.w_in = in[1]; P.b_in = in[2]; P.conv_w = in[3]; P.conv_b = in[4]; P.lru_wa = in[5]; P.lru_ba = in[6]; P.lru_wx = in[7];
  P.lru_bx = in[8]; P.lru_lambda = in[9]; P.cmp_pos_k = in[10]; P.cmpk_w1 = in[11]; P.cmpk_b1 = in[12]; P.cmpk_w2 = in[13]; P.cmpk_b2 = in[14];
  P.cmp_pos_v = in[15]; P.cmpv_w1 = in[16]; P.cmpv_b1 = in[17]; P.cmpv_w2 = in[18]; P.cmpv_b2 = in[19]; P.gn_lru_g = in[20]; P.gn_nsa_g = in[21];
  P.w_out = in[22]; P.ln1_g = in[23]; P.ln1_b = in[24]; P.peer_wq = in[25]; P.peer_subkeys = in[26]; P.peer_u = in[27]; P.peer_v = in[28];
  P.ln2_g = in[29]; P.ln2_b = in[30];
  P.out = (float*)d_out;
  char* ws = (char*)d_ws; size_t off = 0;
  auto take = [&](size_t bytes) { char* p = ws + off; off += (bytes + 255) & ~(size_t)255; return p; };
  P.WinT = (bf16_t*)take((size_t)2 * NINP * 1024 * 2);
  P.WoutT = (bf16_t*)take((size_t)2 * 1024 * 1024 * 2);
  P.WqT = (bf16_t*)take((size_t)2 * 2048 * 1024 * 2);
  P.SK = (bf16_t*)take((size_t)2 * 2 * 128 * 128 * 2);
  P.W1T = (bf16_t*)take((size_t)4 * 64 * 2048 * 2);
  P.KC = (bf16_t*)take((size_t)8 * 2 * 256 * 64 * 2);
  P.VCT = (bf16_t*)take((size_t)8 * 2 * 64 * 256 * 2);
  P.AP = (float*)take((size_t)8 * 64 * 512 * 4);
  P.HE = (float*)take((size_t)8 * 64 * 512 * 4);
  P.VsT = (bf16_t*)take((size_t)8 * 2 * 64 * 4096 * 2);
  P.VwT = (bf16_t*)take((size_t)8 * 2 * 64 * 4096 * 2);
  P.U8 = (unsigned char*)take((size_t)2 * 16384 * 768);
  P.V8 = (unsigned char*)take((size_t)2 * 16384 * 512);
  P.SU = (float*)take((size_t)2 * 16384 * 4);
  P.SV = (float*)take((size_t)2 * 16384 * 4);
  P.H = (bf16_t*)take((size_t)T_TOK * HS * 2);
  P.QP = P.H;
  P.XB = (bf16_t*)take((size_t)T_TOK * 1024 * 2);
  P.CAT = (bf16_t*)take((size_t)T_TOK * 1024 * 2);
  P.EXP = (int*)P.CAT;
  P.GATE = (float*)((char*)P.CAT + (size_t)T_TOK * 128 * 4);
  P.HL = (bf16_t*)take((size_t)T_TOK * 512 * 2);
  P.PB = (bf16_t*)take((size_t)T_TOK * 512 * 2);
  P.bar = (unsigned*)take((size_t)(XCD_BAR_WORDS + 2 * 8 * 64) * 4);
  P.WgT = (bf16_t*)take((size_t)2 * 8 * 2 * 64 * 64 * 2);
  P.MIX = (bf16_t*)take((size_t)T_TOK * 1024 * 2);
  if (off > ws_size) { fprintf(stderr, "workspace too small: need %zu have %zu\n", off, ws_size); return; }

  static int grid_blocks = 0;
  if (!grid_blocks) {
    int dev = 0, cus = 0, per_cu = 0;
    hipGetDevice(&dev);
    hipDeviceGetAttribute(&cus, hipDeviceAttributeMultiprocessorCount, dev);
    hipOccupancyMaxActiveBlocksPerMultiprocessor(&per_cu, mega_kernel, 256, 0);
    if (per_cu > 2) per_cu = 2;
    if (per_cu < 1) per_cu = 1;
    grid_blocks = cus * per_cu;
  }
  hipMemsetAsync(P.bar, 0, (size_t)(XCD_BAR_WORDS + 2 * 8 * 64) * 4, stream);
#if ONE_LAUNCH
  int lo = 0, hi = NPHASE;
  void* args[] = {&P, &lo, &hi};
  hipError_t e = hipLaunchCooperativeKernel((void*)mega_kernel, dim3(grid_blocks), dim3(256), args, 0, stream);
  if (e != hipSuccess) fprintf(stderr, "cooperative launch failed: %s (grid %d)\n", hipGetErrorString(e), grid_blocks);
#else
  for (int ph = 0; ph < NPHASE; ++ph) {
    hipLaunchKernelGGL(mega_kernel, dim3(grid_blocks), dim3(256), 0, stream, P, ph, ph + 1);
  }
#endif
}
```
